# Optimizing an MI355X kernel written in HIP

```python
import jax, jax.numpy as jnp
from jax import lax
import numpy as np

D_MODEL = 1024
BATCH = 8
SEQ = 8192
DEPTH = 1

HEAD_DIM = 64
ROT_DIM = HEAD_DIM // 4
ROPE_THETA = 500000.0
DIL_GROUPS = ((128, 1), (512, 4), (2048, 16))
HEADS_PER_DIL_GROUP = 2
N_DIL_HEADS = HEADS_PER_DIL_GROUP * len(DIL_GROUPS)
DSA_Q_HEADS = 6
DSA_KV_HEADS = 2
DSA_TOPK_MAX = 256
IDX_HEADS = 8
IDX_DIM = 64
MEM_LEN = 256
MEM_HEADS = 4
N_BRANCHES = 3
D_FF = 4 * D_MODEL
Q_BLOCK = 128
EPS = 1e-6

DIL_W = N_DIL_HEADS * HEAD_DIM
DIL_OUT_W = HEADS_PER_DIL_GROUP * HEAD_DIM
DSA_Q_W = DSA_Q_HEADS * HEAD_DIM
DSA_KV_W = DSA_KV_HEADS * HEAD_DIM
IDX_Q_W = IDX_HEADS * IDX_DIM
MEM_Q_W = MEM_HEADS * HEAD_DIM
GATE_W = N_BRANCHES * D_MODEL
IN_SPLITS = (DIL_W, DIL_W, DIL_W, DSA_Q_W, DSA_KV_W, DSA_KV_W, IDX_Q_W, IDX_DIM, IDX_HEADS, MEM_Q_W, GATE_W)
IN_COLS = DIL_W * 3 + DSA_Q_W + DSA_KV_W * 2 + IDX_Q_W + IDX_DIM + IDX_HEADS + MEM_Q_W + GATE_W

kernel_name = "hybrid_gated_dilated_dsa_memory_block"


def rms_norm(x, g):
    xf = x.astype(jnp.float32)
    y = xf * lax.rsqrt(jnp.mean(xf * xf, axis=-1, keepdims=True) + EPS)
    return (y * g.astype(jnp.float32)).astype(x.dtype)


def rotary(x, pos):
    half = ROT_DIM // 2
    inv = jnp.power(jnp.float32(ROPE_THETA), -jnp.arange(half, dtype=jnp.float32) / half)
    ang = pos.astype(jnp.float32)[..., None] * inv
    cos = jnp.cos(ang)[:, :, None, :]
    sin = jnp.sin(ang)[:, :, None, :]
    xr = x[..., :ROT_DIM].astype(jnp.float32)
    x1, x2 = xr[..., :half], xr[..., half:]
    rot = jnp.concatenate([x1 * cos - x2 * sin, x2 * cos + x1 * sin], axis=-1).astype(x.dtype)
    return jnp.concatenate([rot, x[..., ROT_DIM:]], axis=-1)


def split_heads(t, n, dh=HEAD_DIM):
    return t.reshape(t.shape[:-1] + (n, dh))


def dilated_window_attention(q, k, v, window, dilation):
    b, s, h, dh = q.shape
    span = window // dilation
    m = s // dilation
    nblk = -(-m // span)
    mp = nblk * span

    def to_sub(t):
        t = t.reshape(b, m, dilation, h, dh).transpose(0, 2, 1, 3, 4)
        return jnp.pad(t, ((0, 0), (0, 0), (0, mp - m), (0, 0), (0, 0)))

    def band(t):
        tp = jnp.pad(to_sub(t), ((0, 0), (0, 0), (span, 0), (0, 0), (0, 0)))
        tp = tp.reshape(b, dilation, nblk + 1, span, h, dh)
        return jnp.concatenate([tp[:, :, :-1], tp[:, :, 1:]], axis=3)

    qs = to_sub(q).reshape(b, dilation, nblk, span, h, dh)
    kb, vb = band(k), band(v)
    sc = jnp.einsum('brnqhd,brnkhd->brnhqk', qs, kb).astype(jnp.float32) * (dh ** -0.5)
    qi = jnp.arange(span)[:, None]
    kj = jnp.arange(2 * span)[None, :]
    dist = span + qi - kj
    in_band = (dist >= 0) & (dist <= span)
    blk = jnp.arange(nblk)[:, None, None]
    mask = in_band[None] & ((blk > 0) | (kj >= span)[None])
    sc = jnp.where(mask[None, None, :, None], sc, -jnp.inf)
    lse = jax.nn.logsumexp(sc, axis=-1)
    p = jnp.exp(sc - lse[..., None]).astype(v.dtype)
    o = jnp.einsum('brnhqk,brnkhd->brnqhd', p, vb)
    o = o.reshape(b, dilation, mp, h, dh)[:, :, :m].transpose(0, 2, 1, 3, 4).reshape(b, s, h, dh)
    lse = lse.transpose(0, 1, 2, 4, 3).reshape(b, dilation, mp, h)[:, :, :m]
    lse = lse.transpose(0, 2, 1, 3).reshape(b, s, h)
    return o, lse


def dsa_attention(q, k, v, qi, ki, wi):
    b, s, hq, dh = q.shape
    hkv = k.shape[2]
    grp = hq // hkv
    topk = min(DSA_TOPK_MAX, s // 4)
    nblk = s // Q_BLOCK
    key_pos = jnp.arange(s)
    gather = jax.vmap(lambda a, i: a[i])

    def blocks(t):
        return t.reshape((b, nblk, Q_BLOCK) + t.shape[2:]).swapaxes(0, 1)

    def one_block(args):
        n, qb, qib, wib = args
        t = n * Q_BLOCK + jnp.arange(Q_BLOCK)
        isc = jax.nn.relu(jnp.einsum('bqhd,bsd->bqhs', qib, ki))
        iscore = jnp.einsum('bqhs,bqh->bqs', isc, wib).astype(jnp.float32)
        causal = key_pos[None, :] <= t[:, None]
        iscore = jnp.where(causal[None], iscore, -jnp.inf)
        _, sel = lax.top_k(iscore, topk)
        valid = sel <= t[None, :, None]
        ks = gather(k, sel)
        vs = gather(v, sel)
        qg = qb.reshape(b, Q_BLOCK, hkv, grp, dh)
        sc = jnp.einsum('bqcgd,bqkcd->bqcgk', qg, ks).astype(jnp.float32) * (dh ** -0.5)
        sc = jnp.where(valid[:, :, None, None, :], sc, -jnp.inf)
        p = jax.nn.softmax(sc, axis=-1).astype(v.dtype)
        o = jnp.einsum('bqcgk,bqkcd->bqcgd', p, vs)
        return o.reshape(b, Q_BLOCK, hq * dh)

    out = lax.map(one_block, (jnp.arange(nblk), blocks(q), blocks(qi), blocks(wi)))
    return out.swapaxes(0, 1).reshape(b, s, hq * dh)


def memory_attention(qc, mem, g_mem, w_mem_kv, g_qc, g_kc):
    b, s = qc.shape[0], qc.shape[1]
    q = rms_norm(split_heads(qc, MEM_HEADS), g_qc)
    kv = (rms_norm(mem, g_mem) @ w_mem_kv).reshape(b, mem.shape[1], 2, MEM_HEADS, HEAD_DIM)
    km = rms_norm(kv[:, :, 0], g_kc)
    vm = kv[:, :, 1]
    sc = jnp.einsum('bshd,bmhd->bhsm', q, km).astype(jnp.float32) * (HEAD_DIM ** -0.5)
    p = jax.nn.softmax(sc, axis=-1).astype(vm.dtype)
    return jnp.einsum('bhsm,bmhd->bshd', p, vm).reshape(b, s, MEM_Q_W)


def hybrid_layer(x, mem, positions, g_mix, g_mem, w_in, g_qa, g_ka, g_qb, g_kb, g_qc, g_kc,
                 w_mem_kv, w_a, w_b, w_c, w_o, g_mlp, w_1, w_2):
    b, s, d = x.shape
    h = rms_norm(x, g_mix)
    proj = h @ w_in
    offs = []
    acc = 0
    for w in IN_SPLITS[:-1]:
        acc += w
        offs.append(acc)
    qa, ka, va, qb, kb, vb, qi, ki, wi, qc, gl = jnp.split(proj, offs, axis=-1)

    qa = rotary(rms_norm(split_heads(qa, N_DIL_HEADS), g_qa), positions)
    ka = rotary(rms_norm(split_heads(ka, N_DIL_HEADS), g_ka), positions)
    va = split_heads(va, N_DIL_HEADS)
    n_g = len(DIL_GROUPS)
    qa = qa.reshape(b, s, n_g, HEADS_PER_DIL_GROUP, HEAD_DIM)
    ka = ka.reshape(b, s, n_g, HEADS_PER_DIL_GROUP, HEAD_DIM)
    va = va.reshape(b, s, n_g, HEADS_PER_DIL_GROUP, HEAD_DIM)
    outs, lses = [], []
    for gi, (win, dil) in enumerate(DIL_GROUPS):
        o_g, l_g = dilated_window_attention(qa[:, :, gi], ka[:, :, gi], va[:, :, gi], win, dil)
        outs.append(o_g)
        lses.append(l_g)
    o_a = jnp.stack(outs, axis=2)
    alpha = jax.nn.softmax(jnp.stack(lses, axis=2), axis=2)
    y_a = (alpha[..., None].astype(o_a.dtype) * o_a).sum(axis=2).reshape(b, s, DIL_OUT_W) @ w_a

    qb = rotary(rms_norm(split_heads(qb, DSA_Q_HEADS), g_qb), positions)
    kb = rotary(rms_norm(split_heads(kb, DSA_KV_HEADS), g_kb), positions)
    vb = split_heads(vb, DSA_KV_HEADS)
    qi = rotary(split_heads(qi, IDX_HEADS, IDX_DIM), positions)
    ki = rotary(ki[:, :, None, :], positions)[:, :, 0]
    wi = wi * ((IDX_HEADS ** -0.5) * (IDX_DIM ** -0.5))
    y_b = dsa_attention(qb, kb, vb, qi, ki, wi) @ w_b

    y_c = memory_attention(qc, mem, g_mem, w_mem_kv, g_qc, g_kc) @ w_c

    gates = jax.nn.sigmoid(gl.astype(jnp.float32)).astype(x.dtype).reshape(b, s, N_BRANCHES, d)
    merged = gates[:, :, 0] * y_a + gates[:, :, 1] * y_b + gates[:, :, 2] * y_c
    x = x + merged @ w_o

    u = rms_norm(x, g_mlp) @ w_1
    return x + jnp.square(jax.nn.relu(u)) @ w_2


def setup_inputs(seed: int = 0) -> dict:
    key = jax.random.key(seed)
    ks = jax.random.split(key, 24)
    f32 = jnp.float32

    def nrm(k, shape, fan_in):
        return jax.random.normal(k, shape, f32) * (fan_in ** -0.5)

    def gain(k, shape):
        return 1.0 + 0.02 * jax.random.normal(k, shape, f32)

    x = jax.random.normal(ks[0], (BATCH, SEQ, D_MODEL), f32)
    mem = jax.random.normal(ks[1], (BATCH, MEM_LEN, D_MODEL), f32)
    offset = jax.random.randint(ks[2], (BATCH, 1), 0, 4096, dtype=jnp.int32)
    positions = offset + jnp.arange(SEQ, dtype=jnp.int32)[None, :]
    L = DEPTH
    return {
        "x": x,
        "mem": mem,
        "positions": positions,
        "g_mix": gain(ks[3], (L, D_MODEL)),
        "g_mem": gain(ks[4], (L, D_MODEL)),
        "w_in": nrm(ks[5], (L, D_MODEL, IN_COLS), D_MODEL),
        "g_qa": gain(ks[6], (L, HEAD_DIM)),
        "g_ka": gain(ks[7], (L, HEAD_DIM)),
        "g_qb": gain(ks[8], (L, HEAD_DIM)),
        "g_kb": gain(ks[9], (L, HEAD_DIM)),
        "g_qc": gain(ks[10], (L, HEAD_DIM)),
        "g_kc": gain(ks[11], (L, HEAD_DIM)),
        "w_mem_kv": nrm(ks[12], (L, D_MODEL, 2 * MEM_HEADS * HEAD_DIM), D_MODEL),
        "w_a": nrm(ks[13], (L, DIL_OUT_W, D_MODEL), DIL_OUT_W),
        "w_b": nrm(ks[14], (L, DSA_Q_W, D_MODEL), DSA_Q_W),
        "w_c": nrm(ks[15], (L, MEM_Q_W, D_MODEL), MEM_Q_W),
        "w_o": nrm(ks[16], (L, D_MODEL, D_MODEL), D_MODEL),
        "g_mlp": gain(ks[17], (L, D_MODEL)),
        "w_1": nrm(ks[18], (L, D_MODEL, D_FF), D_MODEL),
        "w_2": nrm(ks[19], (L, D_FF, D_MODEL), D_FF),
    }


def reference(x, mem, positions, g_mix, g_mem, w_in, g_qa, g_ka, g_qb, g_kb, g_qc, g_kc,
              w_mem_kv, w_a, w_b, w_c, w_o, g_mlp, w_1, w_2):
    for i in range(DEPTH):
        x = hybrid_layer(x, mem, positions, g_mix[i], g_mem[i], w_in[i], g_qa[i], g_ka[i],
                         g_qb[i], g_kb[i], g_qc[i], g_kc[i], w_mem_kv[i], w_a[i], w_b[i],
                         w_c[i], w_o[i], g_mlp[i], w_1[i], w_2[i])
    return x
```

```cpp
#include <hip/hip_runtime.h>
#include <hip/hip_cooperative_groups.h>
#include <cstdio>
#include <cstdint>
namespace cg = cooperative_groups;
namespace pg8 {
#define PG8_LAS __attribute__((address_space(3)))
typedef unsigned short bf16_t;
typedef short bf16x8 __attribute__((ext_vector_type(8)));
typedef float f32x4 __attribute__((ext_vector_type(4)));
typedef unsigned u32x4 __attribute__((ext_vector_type(4)));
constexpr int BM = 256, BK = 64, HALF = 128, HTB = HALF * BK * 2  , STAGE_BYTES = 8 * HTB, NXCD = 8, WGM = 8;

__host__ __device__ __forceinline__ int lds_byte(int r, int c) { const int st = (r >> 4) * 2 + (c >> 5), rr = r & 15, cc = c & 31, ob = rr * 64 + cc * 2; return st * 1024 + (ob ^ (((ob >> 9) & 1) << 5)); }
__host__ __device__ __forceinline__ void stage_rc(int b, int& R, int& C) { const int st = b / 1024, sb = b % 1024, swz = sb ^ (((sb >> 9) & 1) << 5); R = (st >> 1) * 16 + swz / 64; C = (st & 1) * 32 + (swz % 64) / 2; }
__host__ __device__ __forceinline__ int perm32(int rho) { const int n = rho >> 4, i = rho & 15; return 8 * (i >> 2) + 4 * n + (i & 3); }

struct Unit { int pm, pn; };
struct Gemm { const bf16_t* A; const bf16_t* Bt; int M, N, K; };

struct StaticOrder {
    int nM, nN, nwg, G, c;
    __host__ __device__ void init(int M, int N, int G_, int c_) { nM = M / BM; nN = N / BM; nwg = nM * nN; G = G_; c = c_; }
    __host__ __device__ bool next(int i, Unit& u) const {
        const long L = (long)i * G + c; if (L >= nwg) return false;
        int wgid = (int)L; { const int q = nwg / NXCD, r = nwg % NXCD, xcd = wgid % NXCD, off = wgid / NXCD; wgid = (xcd < r ? xcd * (q + 1) : r * (q + 1) + (xcd - r) * q) + off; }
        const int nig = WGM * nN, gid = wgid / nig, fm = gid * WGM, gsz = (nM - fm) < WGM ? (nM - fm) : WGM;
        u.pm = fm + ((wgid % nig) % gsz); u.pn = (wgid % nig) / gsz; return true;
    }
    __device__ __forceinline__ void a_ready(const Unit&) const {}
    __device__ __forceinline__ void done(const Unit&) const {}
};

__device__ __forceinline__ unsigned cvt_pk_bf16(float lo, float hi) { unsigned r; asm volatile("v_cvt_pk_bf16_f32 %0, %1, %2" : "=v"(r) : "v"(lo), "v"(hi)); return r; }
typedef unsigned u32x2 __attribute__((ext_vector_type(2)));
__device__ __forceinline__ float bf_lo(unsigned w) { return __uint_as_float(w << 16); }
__device__ __forceinline__ float bf_hi(unsigned w) { return __uint_as_float(w & 0xffff0000u); }
__device__ __forceinline__ float sigmoidf_(float x) { return __builtin_amdgcn_rcpf(1.0f + __expf(-x)); }
struct EpiProj {
    static constexpr bool PERM = true, AFTER_DRAIN = false;
    bf16_t* Pq; bf16_t* G;
    __device__ __forceinline__ void operator()(const f32x4 (&acc)[2][2][4][2], const Unit& u, int wr, int wc, int fr, int fq) const {
        const bool gate = u.pn >= 11;
        bf16_t* base = gate ? G : Pq; const int ldc = gate ? 3072 : 2816;
        const int colt = (gate ? u.pn - 11 : u.pn) * BM;
        const int row0 = u.pm * BM + wr * 64 + fr, col0 = colt + wc * 32 + 8 * fq;
#pragma unroll
        for (int ai = 0; ai < 2; ++ai)
#pragma unroll
            for (int m = 0; m < 4; ++m) { bf16_t* rowp = base + (size_t)(row0 + ai * HALF + m * 16) * ldc + col0;
#pragma unroll
                for (int bj = 0; bj < 2; ++bj) { f32x4 v0 = acc[ai][bj][m][0], v1 = acc[ai][bj][m][1];
                    if (gate) { v0 = (f32x4){sigmoidf_(v0[0]), sigmoidf_(v0[1]), sigmoidf_(v0[2]), sigmoidf_(v0[3])}; v1 = (f32x4){sigmoidf_(v1[0]), sigmoidf_(v1[1]), sigmoidf_(v1[2]), sigmoidf_(v1[3])}; }
                    u32x4 w; w.x = cvt_pk_bf16(v0[0], v0[1]); w.y = cvt_pk_bf16(v0[2], v0[3]); w.z = cvt_pk_bf16(v1[0], v1[1]); w.w = cvt_pk_bf16(v1[2], v1[3]);
                    *(u32x4*)(rowp + bj * HALF) = w; } }
    }
};
template <int ACT> struct EpiBf16 {
    static constexpr bool PERM = true, AFTER_DRAIN = false;
    bf16_t* O; int ldc;
    __device__ __forceinline__ void operator()(const f32x4 (&acc)[2][2][4][2], const Unit& u, int wr, int wc, int fr, int fq) const {
        const int row0 = u.pm * BM + wr * 64 + fr, col0 = u.pn * BM + wc * 32 + 8 * fq;
#pragma unroll
        for (int ai = 0; ai < 2; ++ai)
#pragma unroll
            for (int m = 0; m < 4; ++m) { bf16_t* rowp = O + (size_t)(row0 + ai * HALF + m * 16) * ldc + col0;
#pragma unroll
                for (int bj = 0; bj < 2; ++bj) { f32x4 v0 = acc[ai][bj][m][0], v1 = acc[ai][bj][m][1];
                    if (ACT == 1) {
#pragma unroll
                        for (int e = 0; e < 4; ++e) { const float a = fmaxf(v0[e], 0.f), b = fmaxf(v1[e], 0.f); v0[e] = a * a; v1[e] = b * b; } }
                    u32x4 w; w.x = cvt_pk_bf16(v0[0], v0[1]); w.y = cvt_pk_bf16(v0[2], v0[3]); w.z = cvt_pk_bf16(v1[0], v1[1]); w.w = cvt_pk_bf16(v1[2], v1[3]);
                    *(u32x4*)(rowp + bj * HALF) = w; } }
    }
};
template <int MODE> struct EpiGate {
    static constexpr bool PERM = false, AFTER_DRAIN = false;
    const bf16_t* G; int gofs; bf16_t* merged;
    __device__ __forceinline__ void operator()(const f32x4 (&acc)[2][2][4][2], const Unit& u, int wr, int wc, int fr, int fq) const {
#pragma unroll
        for (int ai = 0; ai < 2; ++ai)
#pragma unroll
            for (int m = 0; m < 4; ++m) { const size_t r = (size_t)(u.pm * BM + ai * HALF + wr * 64 + m * 16 + fr);
#pragma unroll
                for (int bj = 0; bj < 2; ++bj)
#pragma unroll
                    for (int n = 0; n < 2; ++n) { const int c = u.pn * BM + bj * HALF + wc * 32 + n * 16 + 4 * fq;
                        const u32x2 gw = *(const u32x2*)(G + r * 3072 + gofs + c);
                        f32x4 v = acc[ai][bj][m][n]; v[0] *= bf_lo(gw.x); v[1] *= bf_hi(gw.x); v[2] *= bf_lo(gw.y); v[3] *= bf_hi(gw.y);
                        u32x2* mp = (u32x2*)(merged + r * 1024 + c);
                        if (MODE >= 1) { const u32x2 pw = *mp; v[0] += bf_lo(pw.x); v[1] += bf_hi(pw.x); v[2] += bf_lo(pw.y); v[3] += bf_hi(pw.y); }
                        u32x2 w; w.x = cvt_pk_bf16(v[0], v[1]); w.y = cvt_pk_bf16(v[2], v[3]); *mp = w; } }
    }
};
struct EpiRes {
    static constexpr bool PERM = false, AFTER_DRAIN = false;
    const float* base; float* out;
    __device__ __forceinline__ void operator()(const f32x4 (&acc)[2][2][4][2], const Unit& u, int wr, int wc, int fr, int fq) const {
#pragma unroll
        for (int ai = 0; ai < 2; ++ai)
#pragma unroll
            for (int m = 0; m < 4; ++m) { const size_t r = (size_t)(u.pm * BM + ai * HALF + wr * 64 + m * 16 + fr);
#pragma unroll
                for (int bj = 0; bj < 2; ++bj)
#pragma unroll
                    for (int n = 0; n < 2; ++n) { const int c = u.pn * BM + bj * HALF + wc * 32 + n * 16 + 4 * fq;
                        const f32x4 bs = *(const f32x4*)(base + r * 1024 + c); *(f32x4*)(out + r * 1024 + c) = bs + acc[ai][bj][m][n]; } }
    }
};
template <class Epi, class Sched, bool ALIGN_EPI = false, bool SP2 = false>
__device__ __forceinline__ void gemm_phase(PG8_LAS unsigned char* lds, const Gemm g, const Sched& S, const Epi& E) {
    int tid_l = threadIdx.x; asm volatile("" : "+v"(tid_l));
    const int tid = tid_l, wid = __builtin_amdgcn_readfirstlane(tid >> 6), lane = tid & 63, wr = wid >> 2, wc = wid & 3, fr = lane & 15, fq = lane >> 4;
    const int K = g.K, nt = K / BK;
    unsigned voffA[2], voffB[2];
#pragma unroll
    for (int i = 0; i < 2; ++i) { int R, C; stage_rc(tid * 16 + i * 8192, R, C); const int Rb = Epi::PERM ? ((R & ~31) + perm32(R & 31)) : R;
        voffA[i] = (unsigned)(R * K + C) * 2u; voffB[i] = (unsigned)(Rb * K + C) * 2u; }
    const size_t kstep = (size_t)(BK * 2);
    const size_t hstep = (size_t)HALF * K * 2;
    const size_t tstep = 2 * hstep;
    const unsigned ldsw = (unsigned)wid * 1024u;
    const int aoff = lds_byte(wr * 64 + fr, fq * 8), boff = lds_byte(wc * 32 + fr, fq * 8);
#define PG8_SA(b, h) (((b) * 2 + (h)) * HTB)
#define PG8_SB(b, h) ((4 + (b) * 2 + (h)) * HTB)
#define PG8_STAGE(bufoff, gbase, voff) do { _Pragma("unroll") for (int _i = 0; _i < 2; ++_i) \
        __builtin_amdgcn_global_load_lds((const unsigned*)((const char*)(gbase) + (voff)[_i]), (PG8_LAS unsigned*)(lds + (bufoff) + ldsw + _i * 8192), 16, 0, 0); } while (0)
#define PG8_LDA(dst, b, h) do { _Pragma("unroll") for (int m = 0; m < 4; ++m) _Pragma("unroll") for (int k = 0; k < 2; ++k) dst[m][k] = *(const PG8_LAS bf16x8*)(lds + PG8_SA(b, h) + aoff + m * 2048 + k * 1024); } while (0)
#define PG8_LDB(dst, b, h) do { _Pragma("unroll") for (int n = 0; n < 2; ++n) _Pragma("unroll") for (int k = 0; k < 2; ++k) dst[n][k] = *(const PG8_LAS bf16x8*)(lds + PG8_SB(b, h) + boff + n * 2048 + k * 1024); } while (0)
#define PG8_MMA(ai, bj, At, Bt) do { __builtin_amdgcn_s_setprio(1); _Pragma("unroll") for (int m = 0; m < 4; ++m) _Pragma("unroll") for (int n = 0; n < 2; ++n) _Pragma("unroll") for (int k = 0; k < 2; ++k) \
        acc[ai][bj][m][n] = __builtin_amdgcn_mfma_f32_16x16x32_bf16(Bt[n][k], At[m][k], acc[ai][bj][m][n], 0, 0, 0); __builtin_amdgcn_s_setprio(0); } while (0)
#define PG8_WAIT_V(n) asm volatile("s_waitcnt vmcnt(" #n ")" ::: "memory")
#define PG8_WAIT_L(n) asm volatile("s_waitcnt lgkmcnt(" #n ")" ::: "memory")
#define PG8_BAR __builtin_amdgcn_s_barrier()
#define PG8_SCHED __builtin_amdgcn_sched_barrier(0)
    Unit cur, nxt; int ui = 0;
    if (!S.next(0, cur)) return;
    f32x4 acc[2][2][4][2];
#pragma unroll
    for (int a = 0; a < 2; ++a)
#pragma unroll
        for (int b = 0; b < 2; ++b)
#pragma unroll
            for (int m = 0; m < 4; ++m)
#pragma unroll
                for (int n = 0; n < 2; ++n) acc[a][b][m][n] = (f32x4){0.f, 0.f, 0.f, 0.f};
    bf16x8 At[4][2], B0[2][2], B1[2][2];
    const char* cA = (const char*)g.A + (size_t)cur.pm * tstep; const char* cB = (const char*)g.Bt + (size_t)cur.pn * tstep;
    S.a_ready(cur);
    if constexpr (SP2) {
        PG8_STAGE(PG8_SB(0, 0), cB, voffB); PG8_STAGE(PG8_SB(0, 1), cB + hstep, voffB); PG8_STAGE(PG8_SA(0, 0), cA, voffA); PG8_STAGE(PG8_SA(0, 1), cA + hstep, voffA);
        if (wr == 1) PG8_BAR;
        PG8_WAIT_V(2); PG8_BAR;
        PG8_STAGE(PG8_SB(1, 0), cB + kstep, voffB); PG8_STAGE(PG8_SA(1, 0), cA + kstep, voffA); PG8_STAGE(PG8_SB(1, 1), cB + hstep + kstep, voffB);
        PG8_WAIT_V(6); PG8_BAR;
    } else {
        PG8_STAGE(PG8_SB(0, 0), cB, voffB); PG8_STAGE(PG8_SA(0, 0), cA, voffA); PG8_STAGE(PG8_SB(0, 1), cB + hstep, voffB); PG8_STAGE(PG8_SA(0, 1), cA + hstep, voffA);
        if (wr == 1) PG8_BAR;
        PG8_WAIT_V(4); PG8_BAR;
        PG8_STAGE(PG8_SB(1, 0), cB + kstep, voffB); PG8_STAGE(PG8_SA(1, 0), cA + kstep, voffA); PG8_STAGE(PG8_SB(1, 1), cB + hstep + kstep, voffB);
        PG8_WAIT_V(6); PG8_BAR;
    }
    for (;;) {
        const bool has_next = S.next(ui + 1, nxt);
        const char* nA = has_next ? (const char*)g.A + (size_t)nxt.pm * tstep : cA; const char* nB = has_next ? (const char*)g.Bt + (size_t)nxt.pn * tstep : cB;
        for (int t = 0; t < nt; t += 2) {
            const bool last = (t == nt - 2);
            const char* a1 = cA + (size_t)(t + 1) * kstep;
            const char* a2 = last ? nA : cA + (size_t)(t + 2) * kstep; const char* b2 = last ? nB : cB + (size_t)(t + 2) * kstep;
            const char* a3 = a2 + kstep; const char* b3 = b2 + kstep;
            if (last && has_next) S.a_ready(nxt);
            if constexpr (SP2) {
            PG8_LDB(B0, 0, 0); PG8_LDB(B1, 0, 1); PG8_SCHED; PG8_LDA(At, 0, 0); PG8_STAGE(PG8_SA(1, 1), a1 + hstep, voffA);
            PG8_WAIT_V(8); PG8_WAIT_L(0); PG8_BAR; PG8_MMA(0, 0, At, B0); PG8_MMA(0, 1, At, B1); PG8_BAR; PG8_SCHED;
            PG8_LDA(At, 0, 1); PG8_STAGE(PG8_SB(0, 0), b2, voffB); PG8_STAGE(PG8_SB(0, 1), b2 + hstep, voffB); PG8_STAGE(PG8_SA(0, 0), a2, voffA);
            PG8_WAIT_V(8); PG8_WAIT_L(0); PG8_BAR; PG8_MMA(1, 0, At, B0); PG8_MMA(1, 1, At, B1); PG8_BAR; PG8_SCHED;
            PG8_LDB(B0, 1, 0); PG8_LDB(B1, 1, 1); PG8_SCHED; PG8_LDA(At, 1, 0); PG8_STAGE(PG8_SA(0, 1), a2 + hstep, voffA);
            PG8_WAIT_V(8); PG8_WAIT_L(0); PG8_BAR; PG8_MMA(0, 0, At, B0); PG8_MMA(0, 1, At, B1); PG8_BAR; PG8_SCHED;
            PG8_LDA(At, 1, 1); PG8_STAGE(PG8_SB(1, 0), b3, voffB); PG8_STAGE(PG8_SB(1, 1), b3 + hstep, voffB); PG8_STAGE(PG8_SA(1, 0), a3, voffA);
            PG8_WAIT_V(8); PG8_WAIT_L(0); PG8_BAR; PG8_MMA(1, 0, At, B0); PG8_MMA(1, 1, At, B1); PG8_BAR; PG8_SCHED;
            } else {
            PG8_LDB(B0, 0, 0); PG8_SCHED; PG8_LDA(At, 0, 0); PG8_STAGE(PG8_SA(1, 1), a1 + hstep, voffA);
            PG8_WAIT_L(8); PG8_BAR; PG8_WAIT_L(0); PG8_MMA(0, 0, At, B0); PG8_BAR; PG8_SCHED;
            PG8_LDB(B1, 0, 1); PG8_STAGE(PG8_SB(0, 0), b2, voffB);
            PG8_BAR; PG8_WAIT_L(0); PG8_MMA(0, 1, At, B1); PG8_BAR;
            PG8_LDA(At, 0, 1); PG8_STAGE(PG8_SA(0, 0), a2, voffA);
            PG8_BAR; PG8_WAIT_L(0); PG8_MMA(1, 0, At, B0); PG8_BAR; PG8_SCHED;
            PG8_STAGE(PG8_SB(0, 1), b2 + hstep, voffB);
            PG8_WAIT_V(6); PG8_BAR; PG8_MMA(1, 1, At, B1); PG8_BAR;
            PG8_LDB(B0, 1, 0); PG8_SCHED; PG8_LDA(At, 1, 0); PG8_STAGE(PG8_SA(0, 1), a2 + hstep, voffA);
            PG8_WAIT_L(8); PG8_BAR; PG8_WAIT_L(0); PG8_MMA(0, 0, At, B0); PG8_BAR; PG8_SCHED;
            PG8_LDB(B1, 1, 1); PG8_STAGE(PG8_SB(1, 0), b3, voffB);
            PG8_BAR; PG8_WAIT_L(0); PG8_MMA(0, 1, At, B1); PG8_BAR;
            PG8_LDA(At, 1, 1); PG8_STAGE(PG8_SA(1, 0), a3, voffA);
            PG8_BAR; PG8_WAIT_L(0); PG8_MMA(1, 0, At, B0); PG8_BAR; PG8_SCHED;
            PG8_STAGE(PG8_SB(1, 1), b3 + hstep, voffB);
            PG8_WAIT_V(6); PG8_BAR; PG8_MMA(1, 1, At, B1); PG8_BAR;
            }
        }
        if constexpr (ALIGN_EPI) { if (wr == 0) PG8_BAR; }
        if constexpr (!Epi::AFTER_DRAIN) { E(acc, cur, wr, wc, fr, fq); S.done(cur); }
        if (!has_next) break;
#pragma unroll
        for (int a = 0; a < 2; ++a)
#pragma unroll
            for (int b = 0; b < 2; ++b)
#pragma unroll
                for (int m = 0; m < 4; ++m)
#pragma unroll
                    for (int n = 0; n < 2; ++n) acc[a][b][m][n] = (f32x4){0.f, 0.f, 0.f, 0.f};
        cur = nxt; cA = nA; cB = nB; ++ui;
        if constexpr (ALIGN_EPI) { if (wr == 1) PG8_BAR; }
    }
    PG8_WAIT_V(0);
    if constexpr (!ALIGN_EPI) { if (wr == 0) PG8_BAR; }
    PG8_BAR;
    if constexpr (Epi::AFTER_DRAIN) { E.fused(acc, cur, wr, wc, fr, fq, lds, wid, lane); S.done(cur); }
#undef PG8_SA
#undef PG8_SB
#undef PG8_STAGE
#undef PG8_LDA
#undef PG8_LDB
#undef PG8_MMA
#undef PG8_WAIT_V
#undef PG8_WAIT_L
#undef PG8_BAR
#undef PG8_SCHED
}
}

#define LAS __attribute__((address_space(3)))
typedef unsigned short bf16;
typedef unsigned u32x4 __attribute__((ext_vector_type(4)));
typedef unsigned u32x2 __attribute__((ext_vector_type(2)));
typedef float f32x4 __attribute__((ext_vector_type(4)));
typedef float f32x16 __attribute__((ext_vector_type(16)));
typedef float f32x2 __attribute__((ext_vector_type(2)));
typedef short bf16x8 __attribute__((ext_vector_type(8)));
constexpr int NWAVES = 8;
constexpr int BATCH = 8, SEQ = 8192, DM = 1024, MTOK = BATCH * SEQ, FF = 4096, MEML = 256, MROWS = BATCH * MEML;
constexpr int IN_COLS = 5704, NQ = 2816, NG = 3072, NPROJ = NQ + NG;
constexpr int C_QA = 0, C_KA = 384, C_VA = 768, C_QB = 1152, C_KB = 1536, C_VB = 1664, C_QI = 1792, C_KI = 2304, C_WI = 2368, C_QC = 2376, C_GATE = 2632;
constexpr float EPS = 1e-6f;
constexpr size_t MiB = 1u << 20;
constexpr size_t WS_WIN = 0, WS_WMEM = 12 * MiB, WS_WA = 13 * MiB, WS_WB = 13 * MiB + 256 * 1024, WS_WC = 14 * MiB, WS_WO = 15 * MiB, WS_W1 = 17 * MiB, WS_W2 = 25 * MiB;
constexpr size_t WS_HM = 33 * MiB, WS_MKV = 37 * MiB, WS_H = 40 * MiB, WS_OA = 40 * MiB, WS_OB = 56 * MiB, WS_OC = 104 * MiB;
constexpr size_t WS_CTL = 39 * MiB, CTL_BYTES = 16384;
constexpr size_t WS_LISTS = 136 * MiB;
constexpr size_t WS_PQ = 168 * MiB, WS_G = 520 * MiB, WS_HID = 168 * MiB, WS_MERGED = 168 * MiB, WS_KIF = 904 * MiB, WS_CNT = 912 * MiB, WS_END = 913 * MiB;
constexpr int LDS_BYTES = 159744;
#define LDS_WAIT() asm volatile("s_waitcnt lgkmcnt(0)" ::: "memory")
#define LDS_ORDER() asm volatile("" ::: "memory")
#define MFMA32(a, b, c) __builtin_amdgcn_mfma_f32_32x32x16_bf16((a), (b), (c), 0, 0, 0)

__device__ __forceinline__ unsigned f2bf(float f) { unsigned u = __builtin_bit_cast(unsigned, f); return (u + 0x7fffu + ((u >> 16) & 1u)) >> 16; }
__device__ __forceinline__ unsigned pk2(float lo, float hi) { return f2bf(lo) | (f2bf(hi) << 16); }
__device__ __forceinline__ float bf2f(unsigned short h) { return __uint_as_float(((unsigned)h) << 16); }
__device__ __forceinline__ float wlo(unsigned w) { return __uint_as_float(w << 16); }
__device__ __forceinline__ float whi(unsigned w) { return __uint_as_float(w & 0xffff0000u); }
__device__ __forceinline__ int crow(int reg, int h) { return (reg & 3) + 8 * (reg >> 2) + 4 * h; }
__device__ __forceinline__ float wave_sum(float v) {
#pragma unroll
    for (int o = 1; o < 64; o <<= 1) v += __shfl_xor(v, o);
    return v;
}
__device__ __forceinline__ float wave_min(float v) {
#pragma unroll
    for (int o = 1; o < 64; o <<= 1) v = fminf(v, __shfl_xor(v, o));
    return v;
}
__device__ __forceinline__ float wave_max(float v) {
#pragma unroll
    for (int o = 1; o < 64; o <<= 1) v = fmaxf(v, __shfl_xor(v, o));
    return v;
}
__device__ __forceinline__ bf16x8 pack8(float a0, float a1, float a2, float a3, float a4, float a5, float a6, float a7) {
    u32x4 p; p.x = pk2(a0, a1); p.y = pk2(a2, a3); p.z = pk2(a4, a5); p.w = pk2(a6, a7); return __builtin_bit_cast(bf16x8, p);
}

__device__ __forceinline__ void transpose_item(const float* W, int K, int ldw, int c0, int nvalid, bf16* WT, int r0, int nblk, LAS float* scr, int item, int lane) {
    const int kb = item / nblk, nb = item % nblk, k0 = 64 * kb, n0 = 32 * nb;
    const int nn = n0 + (lane & 31); const bool ok = nn < nvalid;
#pragma unroll 8
    for (int i = 0; i < 32; ++i) { const int kk = 2 * i + (lane >> 5); scr[kk * 33 + (lane & 31)] = ok ? W[(size_t)(k0 + kk) * ldw + c0 + nn] : 0.f; }
    LDS_WAIT();
    const int c = lane & 7;
#pragma unroll
    for (int j = 0; j < 4; ++j) { const int n = (lane >> 3) + 8 * j; const LAS float* s = scr + (8 * c) * 33 + n;
        u32x4 o; o.x = pk2(s[0 * 33], s[1 * 33]); o.y = pk2(s[2 * 33], s[3 * 33]); o.z = pk2(s[4 * 33], s[5 * 33]); o.w = pk2(s[6 * 33], s[7 * 33]);
        *(u32x4*)(WT + (size_t)(r0 + n0 + n) * K + k0 + 8 * c) = o; }
    LDS_WAIT();
}
__device__ __forceinline__ void rms_row_to_bf16(const float* xrow, const float* g, bf16* orow, int lane) {
    const f32x4* xr = (const f32x4*)xrow + lane; const f32x4* gr = (const f32x4*)g + lane;
    f32x4 v[4]; float s = 0.f;
#pragma unroll
    for (int j = 0; j < 4; ++j) { v[j] = xr[64 * j]; s += (v[j].x * v[j].x + v[j].y * v[j].y) + (v[j].z * v[j].z + v[j].w * v[j].w); }
    const float rs = 1.0f / sqrtf(wave_sum(s) * (1.0f / 1024.0f) + EPS);
    u32x2* o8 = (u32x2*)orow + lane;
#pragma unroll
    for (int j = 0; j < 4; ++j) { const f32x4 gg = gr[64 * j]; u32x2 w; w.x = pk2(v[j].x * rs * gg.x, v[j].y * rs * gg.y); w.y = pk2(v[j].z * rs * gg.z, v[j].w * rs * gg.w); o8[64 * j] = w; }
}

struct Args { const float* in[20]; float* out; unsigned char* ws; int ph_lo, ph_hi; };
typedef const __attribute__((address_space(4))) Args* KArgs;

__device__ __forceinline__ void p0_prologue(KArgs a, LAS unsigned char* lds, int gw, int NGW, int wave, int lane) {
    LAS float* scr = (LAS float*)(lds + wave * 16384);
    unsigned char* ws = a->ws;
    constexpr int I0 = 16 * 88, I1 = 16 * 96, I2 = 16 * 16, I3 = 2 * 32, I4 = 6 * 32, I5 = 4 * 32, I6 = 16 * 32, I7 = 16 * 128, I8 = 64 * 32;
    constexpr int NITEMS = I0 + I1 + I2 + I3 + I4 + I5 + I6 + I7 + I8;
    for (int it = gw; it < NITEMS; it += NGW) {
        int r = it;
        if (r < I0) { transpose_item(a->in[5], 1024, IN_COLS, 0, C_GATE, (bf16*)(ws + WS_WIN), 0, 88, scr, r, lane); continue; } r -= I0;
        if (r < I1) { transpose_item(a->in[5], 1024, IN_COLS, C_GATE, NG, (bf16*)(ws + WS_WIN), NQ, 96, scr, r, lane); continue; } r -= I1;
        if (r < I2) { transpose_item(a->in[12], 1024, 512, 0, 512, (bf16*)(ws + WS_WMEM), 0, 16, scr, r, lane); continue; } r -= I2;
        if (r < I3) { transpose_item(a->in[13], 128, 1024, 0, 1024, (bf16*)(ws + WS_WA), 0, 32, scr, r, lane); continue; } r -= I3;
        if (r < I4) { transpose_item(a->in[14], 384, 1024, 0, 1024, (bf16*)(ws + WS_WB), 0, 32, scr, r, lane); continue; } r -= I4;
        if (r < I5) { transpose_item(a->in[15], 256, 1024, 0, 1024, (bf16*)(ws + WS_WC), 0, 32, scr, r, lane); continue; } r -= I5;
        if (r < I6) { transpose_item(a->in[16], 1024, 1024, 0, 1024, (bf16*)(ws + WS_WO), 0, 32, scr, r, lane); continue; } r -= I6;
        if (r < I7) { transpose_item(a->in[18], 1024, FF, 0, FF, (bf16*)(ws + WS_W1), 0, 128, scr, r, lane); continue; } r -= I7;
        transpose_item(a->in[19], FF, 1024, 0, 1024, (bf16*)(ws + WS_W2), 0, 32, scr, r, lane);
    }
    for (int m = gw; m < MTOK; m += NGW) rms_row_to_bf16(a->in[0] + (size_t)m * DM, a->in[3], (bf16*)(ws + WS_H) + (size_t)m * DM, lane);
    for (int m = gw; m < MROWS; m += NGW) rms_row_to_bf16(a->in[1] + (size_t)m * DM, a->in[4], (bf16*)(ws + WS_HM) + (size_t)m * DM, lane);
}

__device__ __forceinline__ void p2_normrot(KArgs a, int gw, int NGW, int lane) {
    bf16* Pq = (bf16*)(a->ws + WS_PQ); bf16* KIF = (bf16*)(a->ws + WS_KIF);
    const int* positions = (const int*)a->in[2];
    const int sub = lane & 7;
    int col0[5]; const float* gp[5]; bool rotf[5], actf[5];
#pragma unroll
    for (int rnd = 0; rnd < 5; ++rnd) {
        const int slot0 = rnd * 8 + (lane >> 3); actf[rnd] = slot0 < 33; const int s = actf[rnd] ? slot0 : 32;
        if (s < 6) { col0[rnd] = C_QA + 64 * s; gp[rnd] = a->in[6]; rotf[rnd] = true; }
        else if (s < 12) { col0[rnd] = C_KA + 64 * (s - 6); gp[rnd] = a->in[7]; rotf[rnd] = true; }
        else if (s < 18) { col0[rnd] = C_QB + 64 * (s - 12); gp[rnd] = a->in[8]; rotf[rnd] = true; }
        else if (s < 20) { col0[rnd] = C_KB + 64 * (s - 18); gp[rnd] = a->in[9]; rotf[rnd] = true; }
        else if (s < 28) { col0[rnd] = C_QI + 64 * (s - 20); gp[rnd] = nullptr; rotf[rnd] = true; }
        else if (s < 29) { col0[rnd] = C_KI; gp[rnd] = nullptr; rotf[rnd] = true; }
        else { col0[rnd] = C_QC + 64 * (s - 29); gp[rnd] = a->in[10]; rotf[rnd] = false; }
        col0[rnd] += 8 * sub;
    }
    u32x4 rawC[5], rawN[5]; int posC, posN;
    {
        const int t0_ = gw < MTOK ? gw : MTOK - 1;
#pragma unroll
        for (int rnd = 0; rnd < 5; ++rnd) rawC[rnd] = *(const u32x4*)(Pq + (size_t)t0_ * NQ + col0[rnd]);
        posC = positions[t0_];
    }
#pragma unroll 1
    for (int tok = gw; tok < MTOK; tok += NGW) {
        {
            const int tn = tok + NGW < MTOK ? tok + NGW : MTOK - 1;
#pragma unroll
            for (int rnd = 0; rnd < 5; ++rnd) rawN[rnd] = *(const u32x4*)(Pq + (size_t)tn * NQ + col0[rnd]);
            posN = positions[tn];
        }
        const float inv = __builtin_amdgcn_exp2f(-(float)sub * 2.3664460711f);
        const float ang = (float)posC * inv;
        const double rev = (double)ang * 0.15915494309189535; const float fr = (float)(rev - floor(rev));
        const float cs = __builtin_amdgcn_cosf(fr), sn = __builtin_amdgcn_sinf(fr);
        float ce[8], se[8];
#pragma unroll
        for (int e = 0; e < 8; ++e) { ce[e] = __shfl(cs, e); se[e] = __shfl(sn, e); }
        bf16* row = Pq + (size_t)tok * NQ;
#pragma unroll
        for (int rnd = 0; rnd < 5; ++rnd) {
            const u32x4 raw = rawC[rnd];
            float v[8] = {wlo(raw.x), whi(raw.x), wlo(raw.y), whi(raw.y), wlo(raw.z), whi(raw.z), wlo(raw.w), whi(raw.w)};
            float ss = 0.f;
#pragma unroll
            for (int e = 0; e < 8; ++e) ss += v[e] * v[e];
            ss += __shfl_xor(ss, 1); ss += __shfl_xor(ss, 2); ss += __shfl_xor(ss, 4);
            const float* g = gp[rnd];
            if (g) { const float rs = 1.0f / sqrtf(ss * (1.0f / 64.0f) + EPS); const f32x4 g0 = *(const f32x4*)(g + 8 * sub), g1 = *(const f32x4*)(g + 8 * sub + 4);
                v[0] *= rs * g0.x; v[1] *= rs * g0.y; v[2] *= rs * g0.z; v[3] *= rs * g0.w; v[4] *= rs * g1.x; v[5] *= rs * g1.y; v[6] *= rs * g1.z; v[7] *= rs * g1.w; }
            float ot[8];
#pragma unroll
            for (int e = 0; e < 8; ++e) ot[e] = __shfl_xor(v[e], 1);
            if (rotf[rnd] && sub < 2) {
                const float sg = sub == 0 ? -1.f : 1.f;
#pragma unroll
                for (int e = 0; e < 8; ++e) v[e] = v[e] * ce[e] + sg * ot[e] * se[e];
            }
            if (actf[rnd]) { u32x4 o; o.x = pk2(v[0], v[1]); o.y = pk2(v[2], v[3]); o.z = pk2(v[4], v[5]); o.w = pk2(v[6], v[7]); *(u32x4*)(row + col0[rnd]) = o;
                if (rnd == 3 && (lane >> 3) == 4) {
                    const int tb_ = tok >> 5, n_ = tok & 31, ks_ = sub >> 1, hi_ = sub & 1;
                    *(u32x4*)(KIF + ((((size_t)tb_ * 4 + ks_) * 2 + hi_) * 32 + n_) * 8) = o; } }
        }
#pragma unroll
        for (int rnd = 0; rnd < 5; ++rnd) rawC[rnd] = rawN[rnd];
        posC = posN;
    }
    bf16* MKV = (bf16*)(a->ws + WS_MKV);
    for (int it = gw; it < MROWS / 2; it += NGW) {
        const int row = 2 * it + (lane >> 5), slot = (lane >> 3) & 3;
        u32x4* p = (u32x4*)(MKV + (size_t)row * 512 + slot * 64 + 8 * sub);
        const u32x4 raw = *p;
        float v[8] = {wlo(raw.x), whi(raw.x), wlo(raw.y), whi(raw.y), wlo(raw.z), whi(raw.z), wlo(raw.w), whi(raw.w)};
        float ss = 0.f;
#pragma unroll
        for (int e = 0; e < 8; ++e) ss += v[e] * v[e];
        ss += __shfl_xor(ss, 1); ss += __shfl_xor(ss, 2); ss += __shfl_xor(ss, 4);
        const float rs = 1.0f / sqrtf(ss * (1.0f / 64.0f) + EPS); const float* g = a->in[11];
        const f32x4 g0 = *(const f32x4*)(g + 8 * sub), g1 = *(const f32x4*)(g + 8 * sub + 4);
        u32x4 o; o.x = pk2(v[0] * rs * g0.x, v[1] * rs * g0.y); o.y = pk2(v[2] * rs * g0.z, v[3] * rs * g0.w); o.z = pk2(v[4] * rs * g1.x, v[5] * rs * g1.y); o.w = pk2(v[6] * rs * g1.z, v[7] * rs * g1.w);
        *p = o;
    }
}

typedef short s16x4e __attribute__((ext_vector_type(4)));
__device__ __forceinline__ s16x4e lds_tr16e(const LAS unsigned char* p) { return __builtin_bit_cast(s16x4e, __builtin_amdgcn_ds_read_tr16_b64_v4i16((LAS s16x4e*)p)); }
constexpr int KROWE = 144, VROWE = 192;
__device__ __forceinline__ void dilated_unit(LAS unsigned char* wl, const bf16* Pq, bf16* OA, int b, int hh, int tb, int r, int lane) {
    const int qi = lane & 31, hi = lane >> 5;
    const int r8 = lane >> 3, ch8 = lane & 7;
    LAS unsigned char* kwr = wl + r8 * KROWE + ch8 * 16; LAS unsigned char* vwr = wl + 4608 + r8 * VROWE + ch8 * 16;
    const LAS unsigned char* krd = wl + qi * KROWE + hi * 16;
    const LAS unsigned char* vrd = wl + 4608 + (4 * hi + ((lane & 15) >> 2)) * VROWE + (((lane >> 4) & 1) * 16 + 4 * (lane & 3)) * 2;
    const int t_q = tb * 512 + r + 16 * qi;
    const size_t rowb = (size_t)b * SEQ;
    f32x16 o0, o1;
#pragma unroll
    for (int i = 0; i < 16; ++i) { o0[i] = 0.f; o1[i] = 0.f; }
    float l = 0.f;
#pragma unroll 1
    for (int g = 0; g < 3; ++g) {
        const int dl = 2 * g, dil = 1 << dl, rho = r & (dil - 1), head = 2 * g + hh;
        const int step = 16 >> dl, m_q = t_q >> dl, m0 = (tb * 512 + r) >> dl, kstart = m0 - 128, mmax = (SEQ >> dl) - 1;
        const int nblk = (129 + 31 * step + 31) >> 5;
        bf16x8 qf[4];
#pragma unroll
        for (int ks = 0; ks < 4; ++ks) qf[ks] = *(const bf16x8*)(Pq + (rowb + t_q) * NQ + C_QA + head * 64 + 16 * ks + 8 * hi);
        u32x4 kgA[4], kgB[4], vgA[4], vgB[4];
#define DL_LOAD(kg_, vg_, kb_) do { const int kbase_ = kstart + 32 * (kb_); \
            _Pragma("unroll") for (int i = 0; i < 4; ++i) { int mk_ = kbase_ + 8 * i + r8; mk_ = mk_ < 0 ? 0 : (mk_ > mmax ? mmax : mk_); \
                const bf16* row_ = Pq + (rowb + ((size_t)mk_ << dl) + rho) * NQ + head * 64 + ch8 * 8; \
                kg_[i] = *(const u32x4*)(row_ + C_KA); vg_[i] = *(const u32x4*)(row_ + C_VA); } } while (0)
#define DL_COMP(kg_, vg_, kb_) do { const int kbase_ = kstart + 32 * (kb_); \
            _Pragma("unroll") for (int i = 0; i < 4; ++i) { *(LAS u32x4*)(kwr + 8 * i * KROWE) = kg_[i]; *(LAS u32x4*)(vwr + 8 * i * VROWE) = vg_[i]; } \
            LDS_ORDER(); \
            f32x16 s_; \
            _Pragma("unroll") for (int i = 0; i < 16; ++i) s_[i] = 0.f; \
            _Pragma("unroll") for (int ks = 0; ks < 4; ++ks) { const bf16x8 kf_ = *(const LAS bf16x8*)(krd + ks * 32); s_ = MFMA32(kf_, qf[ks], s_); } \
            float p_[16]; \
            _Pragma("unroll") for (int i = 0; i < 16; ++i) { const int mka = kbase_ + crow(i, hi); const int dist = m_q - mka; const bool ok = (dist >= 0) && (dist <= 128) && (mka >= 0); \
                p_[i] = ok ? __expf(s_[i] * 0.125f) : 0.f; l += p_[i]; } \
            _Pragma("unroll") for (int st = 0; st < 2; ++st) { \
                const bf16x8 pb = pack8(p_[8 * st + 0], p_[8 * st + 1], p_[8 * st + 2], p_[8 * st + 3], p_[8 * st + 4], p_[8 * st + 5], p_[8 * st + 6], p_[8 * st + 7]); \
                const s16x4e l0_ = lds_tr16e(vrd + st * 16 * VROWE), h0_ = lds_tr16e(vrd + (st * 16 + 8) * VROWE), l1_ = lds_tr16e(vrd + st * 16 * VROWE + 64), h1_ = lds_tr16e(vrd + (st * 16 + 8) * VROWE + 64); \
                o0 = MFMA32(((bf16x8){l0_[0], l0_[1], l0_[2], l0_[3], h0_[0], h0_[1], h0_[2], h0_[3]}), pb, o0); \
                o1 = MFMA32(((bf16x8){l1_[0], l1_[1], l1_[2], l1_[3], h1_[0], h1_[1], h1_[2], h1_[3]}), pb, o1); } \
            LDS_ORDER(); } while (0)
        const int lastk = nblk - 1;
        DL_LOAD(kgA, vgA, 0);
#pragma unroll 1
        for (int kb = 0; kb < nblk; kb += 2) {
            DL_LOAD(kgB, vgB, (kb + 1 < lastk ? kb + 1 : lastk));
            DL_COMP(kgA, vgA, kb);
            DL_LOAD(kgA, vgA, (kb + 2 < lastk ? kb + 2 : lastk));
            if (kb + 1 < nblk) DL_COMP(kgB, vgB, kb + 1);
        }
#undef DL_LOAD
#undef DL_COMP
    }
    l += __shfl_xor(l, 32);
    const float inv = 1.0f / l;
    bf16* orow = OA + (rowb + t_q) * 128 + hh * 64;
#pragma unroll
    for (int g4 = 0; g4 < 4; ++g4) {
        u32x2 w0, w1; w0.x = pk2(o0[4 * g4] * inv, o0[4 * g4 + 1] * inv); w0.y = pk2(o0[4 * g4 + 2] * inv, o0[4 * g4 + 3] * inv);
        w1.x = pk2(o1[4 * g4] * inv, o1[4 * g4 + 1] * inv); w1.y = pk2(o1[4 * g4 + 2] * inv, o1[4 * g4 + 3] * inv);
        *(u32x2*)(orow + 8 * g4 + 4 * hi) = w0; *(u32x2*)(orow + 32 + 8 * g4 + 4 * hi) = w1;
    }
}

__device__ __forceinline__ void mem_unit(LAS unsigned char* wl, const bf16* Pq, const bf16* MKV, bf16* OC, int b, int head, int qb, int lane) {
    const int qi = lane & 31, hi = lane >> 5;
    const int r8 = lane >> 3, ch8 = lane & 7;
    LAS unsigned char* kwr = wl + r8 * KROWE + ch8 * 16; LAS unsigned char* vwr = wl + 4608 + r8 * VROWE + ch8 * 16;
    const LAS unsigned char* krd = wl + qi * KROWE + hi * 16;
    const LAS unsigned char* vrd = wl + 4608 + (4 * hi + ((lane & 15) >> 2)) * VROWE + (((lane >> 4) & 1) * 16 + 4 * (lane & 3)) * 2;
    const size_t tokrow = (size_t)b * SEQ + qb * 32 + qi;
    bf16x8 qf[4];
#pragma unroll
    for (int ks = 0; ks < 4; ++ks) qf[ks] = *(const bf16x8*)(Pq + tokrow * NQ + C_QC + head * 64 + 16 * ks + 8 * hi);
    f32x16 o0, o1;
#pragma unroll
    for (int i = 0; i < 16; ++i) { o0[i] = 0.f; o1[i] = 0.f; }
    float l = 0.f;
    const bf16* Mb = MKV + (size_t)b * MEML * 512;
    u32x4 kgA[4], kgB[4], vgA[4], vgB[4];
#define MM_LOAD(kg_, vg_, kb_) do { _Pragma("unroll") for (int i = 0; i < 4; ++i) { const bf16* row_ = Mb + (size_t)(32 * (kb_) + 8 * i + r8) * 512 + head * 64 + ch8 * 8; \
        kg_[i] = *(const u32x4*)(row_); vg_[i] = *(const u32x4*)(row_ + 256); } } while (0)
#define MM_COMP(kg_, vg_) do { \
        _Pragma("unroll") for (int i = 0; i < 4; ++i) { *(LAS u32x4*)(kwr + 8 * i * KROWE) = kg_[i]; *(LAS u32x4*)(vwr + 8 * i * VROWE) = vg_[i]; } \
        LDS_ORDER(); \
        f32x16 s_; \
        _Pragma("unroll") for (int i = 0; i < 16; ++i) s_[i] = 0.f; \
        _Pragma("unroll") for (int ks = 0; ks < 4; ++ks) { const bf16x8 kf_ = *(const LAS bf16x8*)(krd + ks * 32); s_ = MFMA32(kf_, qf[ks], s_); } \
        float p_[16]; \
        _Pragma("unroll") for (int i = 0; i < 16; ++i) { p_[i] = __expf(s_[i] * 0.125f); l += p_[i]; } \
        _Pragma("unroll") for (int st = 0; st < 2; ++st) { \
            const bf16x8 pb = pack8(p_[8 * st + 0], p_[8 * st + 1], p_[8 * st + 2], p_[8 * st + 3], p_[8 * st + 4], p_[8 * st + 5], p_[8 * st + 6], p_[8 * st + 7]); \
            const s16x4e l0_ = lds_tr16e(vrd + st * 16 * VROWE), h0_ = lds_tr16e(vrd + (st * 16 + 8) * VROWE), l1_ = lds_tr16e(vrd + st * 16 * VROWE + 64), h1_ = lds_tr16e(vrd + (st * 16 + 8) * VROWE + 64); \
            o0 = MFMA32(((bf16x8){l0_[0], l0_[1], l0_[2], l0_[3], h0_[0], h0_[1], h0_[2], h0_[3]}), pb, o0); \
            o1 = MFMA32(((bf16x8){l1_[0], l1_[1], l1_[2], l1_[3], h1_[0], h1_[1], h1_[2], h1_[3]}), pb, o1); } \
        LDS_ORDER(); } while (0)
    MM_LOAD(kgA, vgA, 0);
#pragma unroll 1
    for (int kb = 0; kb < 8; kb += 2) {
        MM_LOAD(kgB, vgB, kb + 1);
        MM_COMP(kgA, vgA);
        MM_LOAD(kgA, vgA, (kb + 2 < 7 ? kb + 2 : 7));
        MM_COMP(kgB, vgB);
    }
#undef MM_LOAD
#undef MM_COMP
    l += __shfl_xor(l, 32);
    const float inv = 1.0f / l;
    bf16* orow = OC + tokrow * 256 + head * 64;
#pragma unroll
    for (int g4 = 0; g4 < 4; ++g4) {
        u32x2 w0, w1; w0.x = pk2(o0[4 * g4] * inv, o0[4 * g4 + 1] * inv); w0.y = pk2(o0[4 * g4 + 2] * inv, o0[4 * g4 + 3] * inv);
        w1.x = pk2(o1[4 * g4] * inv, o1[4 * g4 + 1] * inv); w1.y = pk2(o1[4 * g4 + 2] * inv, o1[4 * g4 + 3] * inv);
        *(u32x2*)(orow + 8 * g4 + 4 * hi) = w0; *(u32x2*)(orow + 32 + 8 * g4 + 4 * hi) = w1;
    }
}

__device__ __forceinline__ int hist_find9(const LAS unsigned* h, int K, int lane, int& above_out) {
    const u32x4 ha = *(const LAS u32x4*)(h + 8 * lane), hb = *(const LAS u32x4*)(h + 8 * lane + 4);
    const int cnt[8] = {(int)ha.x, (int)ha.y, (int)ha.z, (int)ha.w, (int)hb.x, (int)hb.y, (int)hb.z, (int)hb.w};
    int tot = 0;
#pragma unroll
    for (int i = 0; i < 8; ++i) tot += cnt[i];
    int suf = tot;
#pragma unroll
    for (int off = 1; off < 64; off <<= 1) { const int t = __shfl_down(suf, off); if (lane + off < 64) suf += t; }
    const int above = suf - tot;
    const bool pred = (above < K) && (suf >= K);
    int bin = 8 * lane, abv = above, c = above; bool found = false;
#pragma unroll
    for (int i = 7; i >= 0; --i) { if (!found) { if (c + cnt[i] >= K) { bin = 8 * lane + i; abv = c; found = true; } else c += cnt[i]; } }
    const unsigned long long bal = __ballot(pred);
    const int src = bal ? (int)__ffsll((long long)bal) - 1 : 0;
    above_out = __shfl(abv, src);
    return __shfl(bin, src);
}

typedef _Float16 h16x8 __attribute__((ext_vector_type(8)));
constexpr int SB_SC = 0, SB_HIST = 131072, SB_CANDV = 147456, SB_CANDI = 151552, SB_MM = 155648;
constexpr int CCAP = 256;
__device__ __forceinline__ void dsa_select_phase(LAS unsigned char* lds, const bf16* Pq, const bf16* KIF, unsigned short* LISTS, unsigned short* CNT, int G, int bid, int wave, int lane_in) {
    LAS _Float16* sc = (LAS _Float16*)(lds + SB_SC);
    LAS unsigned* hist = (LAS unsigned*)(lds + SB_HIST);
    LAS _Float16* candv = (LAS _Float16*)(lds + SB_CANDV);
    LAS unsigned short* candi = (LAS unsigned short*)(lds + SB_CANDI);
    LAS float* mm = (LAS float*)(lds + SB_MM);
    const int q = wave;
    LAS _Float16* myS = sc + q * 8192;
    LAS unsigned* myHist = hist + q * 512;
    LAS _Float16* myCv = candv + q * CCAP; LAS unsigned short* myCi = candi + q * CCAP;
    bf16x8 nqA[4], nqB[4], nk0[2][4]; u32x4 nwr[4];
#define UNIT_PREFETCH(u_) do { const int b_ = (u_) & 7, t0_ = ((u_) >> 3) * 8; const size_t rowb_ = (size_t)b_ * SEQ; \
        const int m_ = lane_in & 31, hi_ = lane_in >> 5, qq_ = ((m_ >> 2) & 1) * 2 + (m_ >> 4), hh_ = ((m_ >> 3) & 1) * 4 + (m_ & 3); \
        _Pragma("unroll") for (int ks = 0; ks < 4; ++ks) { nqA[ks] = *(const bf16x8*)(Pq + (rowb_ + t0_ + qq_) * NQ + C_QI + hh_ * 64 + 16 * ks + 8 * hi_); nqB[ks] = *(const bf16x8*)(Pq + (rowb_ + t0_ + 4 + qq_) * NQ + C_QI + hh_ * 64 + 16 * ks + 8 * hi_); } \
        _Pragma("unroll") for (int j = 0; j < 4; ++j) nwr[j] = *(const u32x4*)(Pq + (rowb_ + t0_ + (j >> 1) * 4 + 2 * hi_ + (j & 1)) * NQ + C_WI); \
        const int lastp_ = ((t0_ + 8 + 63) >> 6) - 1; const int p0_ = wave < lastp_ ? wave : lastp_; const bf16* kb_ = KIF + (size_t)b_ * (SEQ * 64) + lane_in * 8; \
        _Pragma("unroll") for (int h2 = 0; h2 < 2; ++h2) _Pragma("unroll") for (int ks = 0; ks < 4; ++ks) nk0[h2][ks] = *(const bf16x8*)(kb_ + (size_t)((2 * p0_ + h2) * 4 + ks) * 512); } while (0)
    UNIT_PREFETCH(bid);
#pragma unroll 1
    for (int u = bid; u < MTOK / 8; u += G) {
        const int b = u & 7, t0 = (u >> 3) * 8;
        const size_t rowb = (size_t)b * SEQ;
        {
            int lane = lane_in; asm volatile("" : "+v"(lane));
            const int m = lane & 31, hi = lane >> 5;
            const int qq = ((m >> 2) & 1) * 2 + (m >> 4), hh = ((m >> 3) & 1) * 4 + (m & 3);
            bf16x8 qfA[4], qfB[4];
#pragma unroll
            for (int ks = 0; ks < 4; ++ks) { qfA[ks] = nqA[ks]; qfB[ks] = nqB[ks]; }
            const float WS = 0.04419417382415922f;
            f32x2 wv[4][4];
#pragma unroll
            for (int j = 0; j < 4; ++j) { const u32x4 wr_ = nwr[j];
                wv[j][0] = (f32x2){wlo(wr_.x) * WS, whi(wr_.x) * WS}; wv[j][1] = (f32x2){wlo(wr_.y) * WS, whi(wr_.y) * WS}; wv[j][2] = (f32x2){wlo(wr_.z) * WS, whi(wr_.z) * WS}; wv[j][3] = (f32x2){wlo(wr_.w) * WS, whi(wr_.w) * WS}; }
            const int npp = (t0 + 8 + 63) >> 6;
            const bf16* kbase = KIF + (size_t)b * (SEQ * 64) + lane * 8;
            bf16x8 k0[2][4], k1[2][4];
#define SC_LOAD(buf, pp_) do { _Pragma("unroll") for (int h2 = 0; h2 < 2; ++h2) _Pragma("unroll") for (int ks = 0; ks < 4; ++ks) \
                buf[h2][ks] = *(const bf16x8*)(kbase + (size_t)((2 * (pp_) + h2) * 4 + ks) * 512); } while (0)
#define SC_TILE(qf_, j0_, qofs_, buf_, h2_) do { f32x16 acc; \
                _Pragma("unroll") for (int i = 0; i < 16; ++i) acc[i] = 0.f; \
                _Pragma("unroll") for (int ks = 0; ks < 4; ++ks) acc = MFMA32(qf_[ks], buf_[h2_][ks], acc); \
                f32x2 a0 = {0.f, 0.f}, a1 = {0.f, 0.f}; \
                _Pragma("unroll") for (int i = 0; i < 4; ++i) { \
                    const f32x2 r0 = {__builtin_amdgcn_fmed3f(acc[2 * i], 0.f, INFINITY), __builtin_amdgcn_fmed3f(acc[2 * i + 1], 0.f, INFINITY)}; \
                    const f32x2 r1 = {__builtin_amdgcn_fmed3f(acc[8 + 2 * i], 0.f, INFINITY), __builtin_amdgcn_fmed3f(acc[9 + 2 * i], 0.f, INFINITY)}; \
                    a0 = wv[j0_][i] * r0 + a0; a1 = wv[j0_ + 1][i] * r1 + a1; } \
                const _Float16 h0 = (_Float16)(a0.x + a0.y), h1 = (_Float16)(a1.x + a1.y);     \
                sc[(qofs_ + 2 * hi) * 8192 + key] = h0; sc[(qofs_ + 2 * hi + 1) * 8192 + key] = h1; } while (0)
#define SC_COMP(buf, pp_) do { _Pragma("unroll") for (int h2 = 0; h2 < 2; ++h2) { const int key = 64 * (pp_) + 32 * h2 + m; SC_TILE(qfA, 0, 0, buf, h2); SC_TILE(qfB, 2, 4, buf, h2); } } while (0)
            const int lastp = npp - 1;
#pragma unroll
            for (int h2 = 0; h2 < 2; ++h2)
#pragma unroll
                for (int ks = 0; ks < 4; ++ks) k0[h2][ks] = nk0[h2][ks];
#pragma unroll 1
            for (int pp = wave; pp < npp; pp += 16) {
                SC_LOAD(k1, (pp + 8 < lastp ? pp + 8 : lastp));
                SC_COMP(k0, pp);
                SC_LOAD(k0, (pp + 16 < lastp ? pp + 16 : lastp));
                if (pp + 8 < npp) SC_COMP(k1, pp + 8);
            }
#undef SC_LOAD
#undef SC_TILE
#undef SC_COMP
            *(LAS u32x4*)(myHist + 8 * lane) = (u32x4){0u, 0u, 0u, 0u}; *(LAS u32x4*)(myHist + 8 * lane + 4) = (u32x4){0u, 0u, 0u, 0u};
        }
        __syncthreads();
        { const int un = u + G < MTOK / 8 ? u + G : u; UNIT_PREFETCH(un); }
        const int tq = t0 + q, nk = tq + 1;
        {
            int lane = lane_in; asm volatile("" : "+v"(lane));
            const unsigned long long lt_mask = (1ull << lane) - 1ull;
            unsigned short* drow = LISTS + (size_t)(rowb + tq) * 256;
            int nsel = 0;
            if (t0 + 8 <= 256) {
#pragma unroll 1
                for (int c = 0; c * 64 < nk; ++c) { const int e = c * 64 + lane; if (e < nk) drow[e] = (unsigned short)e; }
                nsel = nk;
            } else {
                float lo, hv;
                {
                    h16x8 vmn, vmx;
#pragma unroll
                    for (int i = 0; i < 8; ++i) { vmn[i] = (_Float16)INFINITY; vmx[i] = (_Float16)(-INFINITY); }
                    int cb = 0;
#pragma unroll 1
                    for (; cb + 512 <= nk; cb += 512) { const h16x8 v = *(const LAS h16x8*)(myS + cb + 8 * lane); vmn = __builtin_elementwise_min(vmn, v); vmx = __builtin_elementwise_max(vmx, v); }
                    if (cb < nk) { const h16x8 v = *(const LAS h16x8*)(myS + cb + 8 * lane);
#pragma unroll
                        for (int i = 0; i < 8; ++i) if (cb + 8 * lane + i < nk) { vmn[i] = vmn[i] < v[i] ? vmn[i] : v[i]; vmx[i] = vmx[i] > v[i] ? vmx[i] : v[i]; } }
                    float a = (float)vmn[0], bmx = (float)vmx[0];
#pragma unroll
                    for (int i = 1; i < 8; ++i) { a = fminf(a, (float)vmn[i]); bmx = fmaxf(bmx, (float)vmx[i]); }
                    lo = wave_min(a); hv = wave_max(bmx);
                }
                const float scale = (hv > lo) ? 511.0f / (hv - lo) : 0.f;
                {
                    int cb = 0;
#pragma unroll 1
                    for (; cb + 512 <= nk; cb += 512) {
                        const h16x8 v = *(const LAS h16x8*)(myS + cb + 8 * lane);
#pragma unroll
                        for (int i = 0; i < 8; ++i) { const unsigned k = (unsigned)fminf(((float)v[i] - lo) * scale, 511.0f); atomicAdd((unsigned*)&myHist[k], 1u); }
                    }
                    if (cb < nk) {
                        const h16x8 v = *(const LAS h16x8*)(myS + cb + 8 * lane);
#pragma unroll
                        for (int i = 0; i < 8; ++i) if (cb + 8 * lane + i < nk) { const unsigned k = (unsigned)fminf(((float)v[i] - lo) * scale, 511.0f); atomicAdd((unsigned*)&myHist[k], 1u); }
                    }
                }
                LDS_WAIT();
                int abv1; const int T = hist_find9(myHist, 256, lane, abv1);
                const int rem2 = 256 - abv1;
                const float Tf = (float)T, Tp1 = (float)(T + 1);
                int ncand = 0;
#pragma unroll 1
                for (int cb = 0; cb < nk; cb += 512) {
                    const h16x8 v = *(const LAS h16x8*)(myS + cb + 8 * lane);
                    const bool full = cb + 512 <= nk;
#pragma unroll
                    for (int i = 0; i < 8; ++i) {
                        const int e = cb + 8 * lane + i; const float vf = (float)v[i]; const float x = (vf - lo) * scale; const bool ok = full || e < nk;
                        const bool sel = ok && x >= Tp1, cnd = ok && x >= Tf && !(x >= Tp1);
                        const unsigned long long ms = __ballot(sel), mc = __ballot(cnd);
                        if (sel) { const int pos = nsel + __popcll(ms & lt_mask); if (pos < 256) drow[pos] = (unsigned short)e; }
                        nsel += __popcll(ms);
                        if (mc) {
                            if (cnd) { const int pos = ncand + __popcll(mc & lt_mask); if (pos < CCAP) { myCv[pos] = v[i]; myCi[pos] = (unsigned short)e; } }
                            ncand += __popcll(mc);
                        }
                    }
                }
                if (ncand > CCAP) ncand = CCAP;
                LDS_WAIT();
#pragma unroll 1
                for (int c0 = 0; c0 < ncand; c0 += 64) {
                    const int ci = c0 + lane; const bool have = ci < ncand;
                    const float vi = have ? (float)myCv[ci] : 0.f; const int ii = have ? (int)myCi[ci] : 0;
                    int rank = 0;
#pragma unroll 1
                    for (int j = 0; j < ncand; ++j) { const float vj = (float)myCv[j]; const int ij = (int)myCi[j]; rank += (vj > vi || (vj == vi && ij < ii)) ? 1 : 0; }
                    const bool sel = have && rank < rem2;
                    const unsigned long long ms = __ballot(sel);
                    if (sel) { const int pos = nsel + __popcll(ms & lt_mask); if (pos < 256) drow[pos] = (unsigned short)ii; }
                    nsel += __popcll(ms);
                }
                if (nsel > 256) nsel = 256;
            }
            if (lane == 0) CNT[rowb + tq] = (unsigned short)nsel;
        }
        __syncthreads();
    }
}
#undef UNIT_PREFETCH

typedef short s16x4 __attribute__((ext_vector_type(4)));
__device__ __forceinline__ s16x4 lds_tr16(const LAS unsigned char* p) { return __builtin_bit_cast(s16x4, __builtin_amdgcn_ds_read_tr16_b64_v4i16((LAS s16x4*)p)); }
constexpr int KROW = 144;
constexpr int VROW = 192;
__device__ __forceinline__ void dsa_attn_phase(LAS unsigned char* lds, const bf16* Pq, const unsigned short* LISTS, const unsigned short* CNT, bf16* OB, int bid, int wave, int lane_in) {
    LAS unsigned char* Vst = lds + wave * 16384;
    LAS unsigned short* Pst = (LAS unsigned short*)(lds + wave * 16384 + 6144);
    LAS unsigned short* myList = (LAS unsigned short*)(lds + wave * 16384 + 6400);
    LAS unsigned char* qst = lds + wave * 16384 + 6912;
    LAS unsigned char* Kst = lds + wave * 16384 + 7424;
    const int b = bid & 7, widx = (bid >> 3) * 8 + wave;
    const size_t rowb = (size_t)b * SEQ;
#pragma unroll 1
    for (int tq = widx; tq < SEQ; tq += 256) {
        int nsel = (int)CNT[rowb + tq]; nsel = nsel < 1 ? 1 : (nsel > 256 ? 256 : nsel); nsel = __builtin_amdgcn_readfirstlane(nsel);
#pragma unroll 1
    for (int c = 0; c < 2; ++c) {
        int lane = lane_in; asm volatile("" : "+v"(lane));
        {
            if (c == 0) {
            const u32x2 lw = *(const u32x2*)(LISTS + (rowb + tq) * 256 + 4 * lane);
            unsigned e0 = lw.x & 0xffffu, e1 = lw.x >> 16, e2 = lw.y & 0xffffu, e3 = lw.y >> 16;
            e0 = e0 > (unsigned)tq ? (unsigned)tq : e0; e1 = e1 > (unsigned)tq ? (unsigned)tq : e1; e2 = e2 > (unsigned)tq ? (unsigned)tq : e2; e3 = e3 > (unsigned)tq ? (unsigned)tq : e3;
            *(LAS u32x2*)(myList + 4 * lane) = (u32x2){e0 | (e1 << 16), e2 | (e3 << 16)};
            }
            if (lane < 32) {
                const int h = lane >> 3, chn = lane & 7;
                const u32x4 qv = lane < 24 ? *(const u32x4*)(Pq + (rowb + tq) * NQ + C_QB + (3 * c + h) * 64 + chn * 8) : (u32x4){0u, 0u, 0u, 0u};
                const int qoff = lane < 24 ? (chn * 64 + h * 16) : ((lane - 24) * 64 + 48);
                *(LAS u32x4*)(qst + qoff) = qv;
            }
        }
        LDS_WAIT();
        const int m = lane & 31, hi = lane >> 5;
        const int r8 = lane >> 3, ch8 = lane & 7;
        f32x16 O0, O1;
#pragma unroll
        for (int i = 0; i < 16; ++i) { O0[i] = 0.f; O1[i] = 0.f; }
        float lp[3] = {0.f, 0.f, 0.f};
        const int nbk = (nsel + 31) >> 5;
        const bf16* kbase = Pq + rowb * NQ + C_KB + c * 64 + ch8 * 8;
        const bf16* vbase = Pq + rowb * NQ + C_VB + c * 64 + ch8 * 8;
        const LAS unsigned char* qrd = qst + hi * 64 + (m < 3 ? m : 3) * 16;
        const LAS unsigned char* prd = (const LAS unsigned char*)Pst + (m < 3 ? m : 2) * 64 + 8 * hi;
        const LAS unsigned char* vrd = Vst + (4 * hi + ((lane & 15) >> 2)) * VROW + (((lane >> 4) & 1) * 16 + 4 * (lane & 3)) * 2;
        LAS unsigned char* vwr = Vst + r8 * VROW + ch8 * 16;
        LAS unsigned char* kwr = Kst + r8 * KROW + ch8 * 16;
        const LAS unsigned char* krd = Kst + m * KROW + hi * 16;
        u32x4 kA[4], kB[4], kC[4]; u32x4 vA[4], vB[4], vC[4];
#define KV_LOAD(kbuf, vbuf, bk_) do { _Pragma("unroll") for (int i = 0; i < 4; ++i) { const int jj_ = 32 * (bk_) + 8 * i + r8; const int key_ = (int)myList[jj_ < 256 ? jj_ : 255]; \
            kbuf[i] = *(const u32x4*)(kbase + (size_t)key_ * NQ); vbuf[i] = *(const u32x4*)(vbase + (size_t)key_ * NQ); } } while (0)
#define BLOCK(kbuf, vbuf, bk_) do { \
            _Pragma("unroll") for (int i = 0; i < 4; ++i) { *(LAS u32x4*)(vwr + 8 * i * VROW) = vbuf[i]; *(LAS u32x4*)(kwr + 8 * i * KROW) = kbuf[i]; } \
            LDS_ORDER(); \
            { f32x16 sacc; \
                _Pragma("unroll") for (int i = 0; i < 16; ++i) sacc[i] = 0.f; \
                _Pragma("unroll") for (int ks = 0; ks < 4; ++ks) { const bf16x8 qa = *(const LAS bf16x8*)(qrd + ks * 128); const bf16x8 kf = *(const LAS bf16x8*)(krd + ks * 32); sacc = MFMA32(qa, kf, sacc); } \
                const bool pv_ = (lane < 32) && (32 * (bk_) + m < nsel); \
                _Pragma("unroll") for (int g = 0; g < 3; ++g) { const float p = pv_ ? __expf(sacc[g] * 0.125f) : 0.f; lp[g] += p; if (lane < 32) Pst[g * 32 + m] = (unsigned short)f2bf(p); } } \
            LDS_ORDER(); \
            _Pragma("unroll") for (int s2 = 0; s2 < 2; ++s2) { \
                const u32x2 pl = *(const LAS u32x2*)(prd + s2 * 32), ph = *(const LAS u32x2*)(prd + s2 * 32 + 16); \
                const bf16x8 pb = __builtin_bit_cast(bf16x8, (u32x4){pl.x, pl.y, ph.x, ph.y}); \
                _Pragma("unroll") for (int db = 0; db < 2; ++db) { \
                    const s16x4 vl = lds_tr16(vrd + s2 * 16 * VROW + db * 64), vh = lds_tr16(vrd + (s2 * 16 + 8) * VROW + db * 64); \
                    const bf16x8 va = (bf16x8){vl[0], vl[1], vl[2], vl[3], vh[0], vh[1], vh[2], vh[3]}; \
                    if (db == 0) O0 = MFMA32(va, pb, O0); else O1 = MFMA32(va, pb, O1); } } \
            LDS_ORDER(); } while (0)
        KV_LOAD(kA, vA, 0);
        KV_LOAD(kB, vB, 1);
#pragma unroll 1
        for (int bk = 0; bk < nbk; bk += 3) {
            KV_LOAD(kC, vC, bk + 2);
            BLOCK(kA, vA, bk);
            KV_LOAD(kA, vA, bk + 3);
            if (bk + 1 < nbk) BLOCK(kB, vB, bk + 1);
            KV_LOAD(kB, vB, bk + 4);
            if (bk + 2 < nbk) BLOCK(kC, vC, bk + 2);
        }
#undef KV_LOAD
#undef BLOCK
#pragma unroll
        for (int h = 0; h < 3; ++h) lp[h] = wave_sum(lp[h]);
        if (m < 3) {
            const float l0 = m == 0 ? lp[0] : (m == 1 ? lp[1] : lp[2]);
            const float i0 = 1.0f / l0;
            bf16* o0 = OB + (rowb + tq) * 384 + (3 * c + m) * 64 + 4 * hi;
#pragma unroll
            for (int g4 = 0; g4 < 4; ++g4) {
                u32x2 w;
                w.x = pk2(O0[4 * g4] * i0, O0[4 * g4 + 1] * i0); w.y = pk2(O0[4 * g4 + 2] * i0, O0[4 * g4 + 3] * i0); *(u32x2*)(o0 + 8 * g4) = w;
                w.x = pk2(O1[4 * g4] * i0, O1[4 * g4 + 1] * i0); w.y = pk2(O1[4 * g4 + 2] * i0, O1[4 * g4 + 3] * i0); *(u32x2*)(o0 + 32 + 8 * g4) = w;
            }
        }
        LDS_WAIT();
    }
    }
}

#define XB_TMO      128
#define XB_XCNT(j)  (256  + 64 * (j))
#define XB_XSUB(j)  (1280 + 64 * (j))
#define XB_XGEN(j)  (2304 + 64 * (j))
#define XB_TOP      3328
#define XB_TOPGEN   3392
#define XCD_BAR_WORDS 3456
#define XB_SPIN_CAP (1u << 18)

__device__ __forceinline__ unsigned xb_ld(unsigned* p)              { return __hip_atomic_load(p, __ATOMIC_RELAXED, __HIP_MEMORY_SCOPE_AGENT); }
__device__ __forceinline__ unsigned xb_add(unsigned* p, unsigned v) { return __hip_atomic_fetch_add(p, v, __ATOMIC_RELAXED, __HIP_MEMORY_SCOPE_AGENT); }
__device__ __forceinline__ unsigned xb_xcc_id() { return (unsigned)__builtin_amdgcn_s_getreg((3 << 11) | 20) & 0xFu; }
#define XB_SPIN(cond, bar) do { unsigned _sp = 0; while (cond) { __builtin_amdgcn_s_sleep(1); \
    if ((++_sp & 255u) == 0u) { if (xb_ld(&(bar)[XB_TMO])) break; if (_sp > XB_SPIN_CAP) { atomicAdd(&(bar)[XB_TMO], 1u); break; } } } } while (0)

struct XcdBarrier {
    unsigned* bar; unsigned x;
    volatile LAS unsigned* st;
};

__device__ __forceinline__ XcdBarrier xcd_barrier_post(unsigned* bar, volatile LAS unsigned* st) {
    XcdBarrier b; b.bar = bar; b.x = xb_xcc_id(); b.st = st;
    if (threadIdx.x == 0) (void)xb_add(&bar[XB_XCNT(b.x)], 1u);
    return b;
}
__device__ __forceinline__ void xcd_barrier_complete(unsigned* bar, unsigned x, unsigned& nloc, unsigned& nx) {
    const unsigned G = gridDim.x * gridDim.y * gridDim.z;
    unsigned sum, cnt, mine, sp = 0u;
    for (;;) {
        sum = 0u; cnt = 0u; mine = 0u;
#pragma unroll
        for (unsigned j = 0; j < 16; ++j) { const unsigned c = xb_ld(&bar[XB_XCNT(j)]); sum += c; cnt += (c > 0u) ? 1u : 0u; mine = (j == x) ? c : mine; }
        if (sum == G) break;
        __builtin_amdgcn_s_sleep(1);
        if ((++sp & 255u) == 0u) { if (xb_ld(&bar[XB_TMO])) break; if (sp > XB_SPIN_CAP) { atomicAdd(&bar[XB_TMO], 1u); break; } }
    }
    nloc = mine > 0u ? mine : 1u; nx = cnt > 0u ? cnt : 1u;
}

__device__ __forceinline__ void xcd_barrier(const XcdBarrier& b) {
    asm volatile("s_waitcnt vmcnt(0)" ::: "memory");
    __syncthreads();
    if (threadIdx.x == 0) {
        unsigned* bar = b.bar;
        __builtin_amdgcn_s_waitcnt(0);
        unsigned nloc = b.st[0], nx = b.st[1];
        if (nloc == 0u) { xcd_barrier_complete(bar, b.x, nloc, nx); b.st[0] = nloc; b.st[1] = nx; }
        const unsigned old = xb_add(&bar[XB_XSUB(b.x)], 1u);
        const unsigned gen = old / nloc;
        if (old + 1u == (gen + 1u) * nloc) {
            __builtin_amdgcn_fence(__ATOMIC_RELEASE, "agent");
            asm volatile("s_waitcnt vmcnt(0)" ::: "memory");
            const unsigned og = xb_add(&bar[XB_TOP], 1u);
            const unsigned tg = og / nx;
            if (og + 1u == (tg + 1u) * nx) xb_add(&bar[XB_TOPGEN], 1u);
            else XB_SPIN(xb_ld(&bar[XB_TOPGEN]) == tg, bar);
            __builtin_amdgcn_fence(__ATOMIC_ACQUIRE, "agent");
            xb_add(&bar[XB_XGEN(b.x)], 1u);
            asm volatile("s_waitcnt vmcnt(0)" ::: "memory");
        } else {
            XB_SPIN(xb_ld(&bar[XB_XGEN(b.x)]) == gen, bar);
            __builtin_amdgcn_fence(__ATOMIC_ACQUIRE, "agent");
            asm volatile("s_waitcnt vmcnt(0)" ::: "memory");
        }
    }
    __syncthreads();
}

__global__ void __launch_bounds__(NWAVES * 64, 2) hybrid_fwd(Args args) {
    extern __shared__ __attribute__((aligned(16))) unsigned char lds_raw[];
    LAS unsigned char* lds = (LAS unsigned char*)lds_raw;
    const int G = gridDim.x, bid = blockIdx.x, NGW = G * NWAVES;
#define IDS int tid_ = threadIdx.x; asm volatile("" : "+v"(tid_)); const int lane = tid_ & 63, wave = __builtin_amdgcn_readfirstlane(tid_ >> 6), gw = bid * NWAVES + wave; (void)lane; (void)gw
    const int lo = args.ph_lo, hi = args.ph_hi;
    cg::grid_group grid = cg::this_grid();
    volatile LAS unsigned* bst = (volatile LAS unsigned*)(lds + LDS_BYTES - 16);
    if (threadIdx.x < 2) bst[threadIdx.x] = 0u;
    __syncthreads();
    XcdBarrier xbar = xcd_barrier_post((unsigned*)(args.ws + WS_CTL), bst);
#define IN(k) (lo <= (k) && (k) < hi)
#define KA KArgs ap = (KArgs)__builtin_amdgcn_kernarg_segment_ptr(); asm volatile("" : "+s"(ap)); unsigned char* ws = ap->ws; bf16* Pq = (bf16*)(ws + WS_PQ); bf16* Gt = (bf16*)(ws + WS_G); (void)Pq; (void)Gt
#define SEAM(k) do { if (IN(k) && IN((k) + 1)) xcd_barrier(xbar); } while (0)
    if (hi < 0) grid.sync();
    if (IN(0)) { IDS; KA; p0_prologue(ap, lds, gw, NGW, wave, lane); }
    SEAM(0);
    if (IN(1)) {
        KA;
        { pg8::Gemm g{(const bf16*)(ws + WS_H), (const bf16*)(ws + WS_WIN), MTOK, NPROJ, DM}; pg8::StaticOrder S; S.init(MTOK, NPROJ, G, bid);
          pg8::EpiProj E{Pq, Gt}; pg8::gemm_phase<pg8::EpiProj, pg8::StaticOrder, true, true>(lds, g, S, E); }
        __syncthreads();
        { pg8::Gemm g{(const bf16*)(ws + WS_HM), (const bf16*)(ws + WS_WMEM), MROWS, 512, DM}; pg8::StaticOrder S; S.init(MROWS, 512, G, bid);
          pg8::EpiBf16<0> E{(bf16*)(ws + WS_MKV), 512}; pg8::gemm_phase<pg8::EpiBf16<0>, pg8::StaticOrder, true, true>(lds, g, S, E); }
    }
    SEAM(1);
    if (IN(2)) { IDS; KA; p2_normrot(ap, gw, NGW, lane); }
    SEAM(2);
    if (IN(3)) {
        IDS; KA;
        for (int uid = gw; uid < 4096; uid += NGW) dilated_unit(lds + wave * 16384, Pq, (bf16*)(ws + WS_OA), uid >> 9, (uid >> 8) & 1, (uid >> 4) & 15, uid & 15, lane);
        for (int uid = gw; uid < 8192; uid += NGW) mem_unit(lds + wave * 16384, Pq, (const bf16*)(ws + WS_MKV), (bf16*)(ws + WS_OC), uid >> 10, (uid >> 8) & 3, uid & 255, lane);
        __syncthreads();
        dsa_select_phase(lds, Pq, (const bf16*)(ws + WS_KIF), (unsigned short*)(ws + WS_LISTS), (unsigned short*)(ws + WS_CNT), G, bid, wave, lane);
        xcd_barrier(xbar);
        dsa_attn_phase(lds, Pq, (const unsigned short*)(ws + WS_LISTS), (const unsigned short*)(ws + WS_CNT), (bf16*)(ws + WS_OB), bid, wave, lane);
    }
    SEAM(3);
    if (IN(4)) {
        KA; bf16* mrg = (bf16*)(ws + WS_MERGED);
        pg8::StaticOrder S; S.init(MTOK, DM, G, bid);
        { pg8::Gemm g{(const bf16*)(ws + WS_OA), (const bf16*)(ws + WS_WA), MTOK, DM, 128}; pg8::EpiGate<0> E{Gt, 0, mrg};
          pg8::gemm_phase<pg8::EpiGate<0>, pg8::StaticOrder, true, true>(lds, g, S, E); }
        __syncthreads();
        { pg8::Gemm g{(const bf16*)(ws + WS_OB), (const bf16*)(ws + WS_WB), MTOK, DM, 384}; pg8::EpiGate<1> E{Gt, 1024, mrg};
          pg8::gemm_phase<pg8::EpiGate<1>, pg8::StaticOrder, true, true>(lds, g, S, E); }
        __syncthreads();
        { pg8::Gemm g{(const bf16*)(ws + WS_OC), (const bf16*)(ws + WS_WC), MTOK, DM, 256}; pg8::EpiGate<1> E{Gt, 2048, mrg};
          pg8::gemm_phase<pg8::EpiGate<1>, pg8::StaticOrder, true, true>(lds, g, S, E); }
    }
    SEAM(4);
    if (IN(5)) {
        KA;
        pg8::Gemm g{(const bf16*)(ws + WS_MERGED), (const bf16*)(ws + WS_WO), MTOK, DM, DM}; pg8::StaticOrder S; S.init(MTOK, DM, G, bid);
        pg8::EpiRes E{ap->in[0], ap->out}; pg8::gemm_phase<pg8::EpiRes, pg8::StaticOrder, true, true>(lds, g, S, E);
    }
    SEAM(5);
    if (IN(6)) { IDS; KA; const float* xo_ = ap->out; const float* gm_ = ap->in[17]; for (int m = gw; m < MTOK; m += NGW) rms_row_to_bf16(xo_ + (size_t)m * DM, gm_, (bf16*)(ws + WS_H) + (size_t)m * DM, lane); }
    SEAM(6);
    if (IN(7)) {
        KA;
        pg8::Gemm g{(const bf16*)(ws + WS_H), (const bf16*)(ws + WS_W1), MTOK, FF, DM}; pg8::StaticOrder S; S.init(MTOK, FF, G, bid);
        pg8::EpiBf16<1> E{(bf16*)(ws + WS_HID), FF}; pg8::gemm_phase<pg8::EpiBf16<1>, pg8::StaticOrder, true, true>(lds, g, S, E);
    }
    SEAM(7);
    if (IN(8)) {
        KA; float* outp = ap->out;
        pg8::Gemm g{(const bf16*)(ws + WS_HID), (const bf16*)(ws + WS_W2), MTOK, DM, FF}; pg8::StaticOrder S; S.init(MTOK, DM, G, bid);
        pg8::EpiRes E{outp, outp}; pg8::gemm_phase<pg8::EpiRes, pg8::StaticOrder, true, true>(lds, g, S, E);
    }
#undef IN
#undef KA
#undef SEAM
}

#ifndef MK_ONE_LAUNCH
#define MK_ONE_LAUNCH 1
#endif
constexpr int N_PHASES = 9;
extern "C" void kernel_launch(void* const* d_in, const int* in_sizes, int n_in, void* d_out, int out_size, void* d_ws, size_t ws_size, hipStream_t stream) {
    static int grid = 0;
    if (grid == 0) {
        if (n_in != 20 || out_size != MTOK * DM || ws_size < WS_END) { fprintf(stderr, "kernel_launch: unexpected shapes: n_in %d out %d ws %zu (need %zu)\n", n_in, out_size, ws_size, (size_t)WS_END); grid = -1; return; }
        int dev = 0, cus = 0, per_cu = 0;
        hipGetDevice(&dev); hipDeviceGetAttribute(&cus, hipDeviceAttributeMultiprocessorCount, dev);
        if (hipFuncSetAttribute((const void*)hybrid_fwd, hipFuncAttributeMaxDynamicSharedMemorySize, LDS_BYTES) != hipSuccess) { fprintf(stderr, "kernel_launch: hipFuncSetAttribute failed\n"); grid = -1; return; }
        if (hipOccupancyMaxActiveBlocksPerMultiprocessor(&per_cu, (const void*)hybrid_fwd, NWAVES * 64, LDS_BYTES) != hipSuccess || per_cu < 1) { fprintf(stderr, "kernel_launch: occupancy query says %d\n", per_cu); per_cu = 1; }
        (void)hipGetLastError();
        grid = cus > 0 ? cus : 256;
    }
    if (grid < 0) return;
    if (hipMemsetAsync((char*)d_ws + WS_CTL, 0, CTL_BYTES, stream) != hipSuccess) { fprintf(stderr, "kernel_launch: hipMemsetAsync failed\n"); return; }
    Args a{};
    for (int i = 0; i < 20; ++i) a.in[i] = (const float*)d_in[i];
    a.out = (float*)d_out; a.ws = (unsigned char*)d_ws;
#if MK_ONE_LAUNCH
    a.ph_lo = 0; a.ph_hi = N_PHASES;
    void* kargs[] = {&a};
    hipError_t e = hipLaunchCooperativeKernel((const void*)hybrid_fwd, dim3(grid), dim3(NWAVES * 64), kargs, LDS_BYTES, stream);
    if (e != hipSuccess) fprintf(stderr, "kernel_launch: cooperative launch failed: %s (grid %d)\n", hipGetErrorString(e), grid);
#else
    for (int p = 0; p < N_PHASES; ++p) {
        a.ph_lo = p; a.ph_hi = p + 1;
        hipLaunchKernelGGL(hybrid_fwd, dim3(grid), dim3(NWAVES * 64), LDS_BYTES, stream, a);
    }
#endif
}
```

```cpp
#include <hip/hip_runtime.h>
#include <hip/hip_cooperative_groups.h>
#include <cstdio>
#include <cstdint>
namespace cg = cooperative_groups;
namespace pg8 {
#define PG8_LAS __attribute__((address_space(3)))
typedef unsigned short bf16_t;
typedef short bf16x8 __attribute__((ext_vector_type(8)));
typedef float f32x4 __attribute__((ext_vector_type(4)));
typedef unsigned u32x4 __attribute__((ext_vector_type(4)));
constexpr int BM = 256, BK = 64, HALF = 128, HTB = HALF * BK * 2  , STAGE_BYTES = 8 * HTB, NXCD = 8, WGM = 8;

__host__ __device__ __forceinline__ int lds_byte(int r, int c) { const int st = (r >> 4) * 2 + (c >> 5), rr = r & 15, cc = c & 31, ob = rr * 64 + cc * 2; return st * 1024 + (ob ^ (((ob >> 9) & 1) << 5)); }
__host__ __device__ __forceinline__ void stage_rc(int b, int& R, int& C) { const int st = b / 1024, sb = b % 1024, swz = sb ^ (((sb >> 9) & 1) << 5); R = (st >> 1) * 16 + swz / 64; C = (st & 1) * 32 + (swz % 64) / 2; }
__host__ __device__ __forceinline__ int perm32(int rho) { const int n = rho >> 4, i = rho & 15; return 8 * (i >> 2) + 4 * n + (i & 3); }

struct Unit { int pm, pn; };
struct Gemm { const bf16_t* A; const bf16_t* Bt; int M, N, K; };

struct StaticOrder {
    int nM, nN, nwg, G, c;
    __host__ __device__ void init(int M, int N, int G_, int c_) { nM = M / BM; nN = N / BM; nwg = nM * nN; G = G_; c = c_; }
    __host__ __device__ bool next(int i, Unit& u) const {
        const long L = (long)i * G + c; if (L >= nwg) return false;
        int wgid = (int)L; { const int q = nwg / NXCD, r = nwg % NXCD, xcd = wgid % NXCD, off = wgid / NXCD; wgid = (xcd < r ? xcd * (q + 1) : r * (q + 1) + (xcd - r) * q) + off; }
        const int nig = WGM * nN, gid = wgid / nig, fm = gid * WGM, gsz = (nM - fm) < WGM ? (nM - fm) : WGM;
        u.pm = fm + ((wgid % nig) % gsz); u.pn = (wgid % nig) / gsz; return true;
    }
    __device__ __forceinline__ void a_ready(const Unit&) const {}
    __device__ __forceinline__ void done(const Unit&) const {}
};

__device__ __forceinline__ unsigned cvt_pk_bf16(float lo, float hi) { unsigned r; asm volatile("v_cvt_pk_bf16_f32 %0, %1, %2" : "=v"(r) : "v"(lo), "v"(hi)); return r; }
typedef unsigned u32x2 __attribute__((ext_vector_type(2)));
__device__ __forceinline__ float bf_lo(unsigned w) { return __uint_as_float(w << 16); }
__device__ __forceinline__ float bf_hi(unsigned w) { return __uint_as_float(w & 0xffff0000u); }
__device__ __forceinline__ float sigmoidf_(float x) { return __builtin_amdgcn_rcpf(1.0f + __expf(-x)); }
struct EpiProj {
    static constexpr bool PERM = true, AFTER_DRAIN = false;
    bf16_t* Pq; bf16_t* G;
    __device__ __forceinline__ void operator()(const f32x4 (&acc)[2][2][4][2], const Unit& u, int wr, int wc, int fr, int fq) const {
        const bool gate = u.pn >= 11;
        bf16_t* base = gate ? G : Pq; const int ldc = gate ? 3072 : 2816;
        const int colt = (gate ? u.pn - 11 : u.pn) * BM;
        const int row0 = u.pm * BM + wr * 64 + fr, col0 = colt + wc * 32 + 8 * fq;
#pragma unroll
        for (int ai = 0; ai < 2; ++ai)
#pragma unroll
            for (int m = 0; m < 4; ++m) { bf16_t* rowp = base + (size_t)(row0 + ai * HALF + m * 16) * ldc + col0;
#pragma unroll
                for (int bj = 0; bj < 2; ++bj) { f32x4 v0 = acc[ai][bj][m][0], v1 = acc[ai][bj][m][1];
                    if (gate) { v0 = (f32x4){sigmoidf_(v0[0]), sigmoidf_(v0[1]), sigmoidf_(v0[2]), sigmoidf_(v0[3])}; v1 = (f32x4){sigmoidf_(v1[0]), sigmoidf_(v1[1]), sigmoidf_(v1[2]), sigmoidf_(v1[3])}; }
                    u32x4 w; w.x = cvt_pk_bf16(v0[0], v0[1]); w.y = cvt_pk_bf16(v0[2], v0[3]); w.z = cvt_pk_bf16(v1[0], v1[1]); w.w = cvt_pk_bf16(v1[2], v1[3]);
                    *(u32x4*)(rowp + bj * HALF) = w; } }
    }
};
template <int ACT> struct EpiBf16 {
    static constexpr bool PERM = true, AFTER_DRAIN = false;
    bf16_t* O; int ldc;
    __device__ __forceinline__ void operator()(const f32x4 (&acc)[2][2][4][2], const Unit& u, int wr, int wc, int fr, int fq) const {
        const int row0 = u.pm * BM + wr * 64 + fr, col0 = u.pn * BM + wc * 32 + 8 * fq;
#pragma unroll
        for (int ai = 0; ai < 2; ++ai)
#pragma unroll
            for (int m = 0; m < 4; ++m) { bf16_t* rowp = O + (size_t)(row0 + ai * HALF + m * 16) * ldc + col0;
#pragma unroll
                for (int bj = 0; bj < 2; ++bj) { f32x4 v0 = acc[ai][bj][m][0], v1 = acc[ai][bj][m][1];
                    if (ACT == 1) {
#pragma unroll
                        for (int e = 0; e < 4; ++e) { const float a = fmaxf(v0[e], 0.f), b = fmaxf(v1[e], 0.f); v0[e] = a * a; v1[e] = b * b; } }
                    u32x4 w; w.x = cvt_pk_bf16(v0[0], v0[1]); w.y = cvt_pk_bf16(v0[2], v0[3]); w.z = cvt_pk_bf16(v1[0], v1[1]); w.w = cvt_pk_bf16(v1[2], v1[3]);
                    *(u32x4*)(rowp + bj * HALF) = w; } }
    }
};
template <int MODE> struct EpiGate {
    static constexpr bool PERM = true, AFTER_DRAIN = false;
    const bf16_t* G; int gofs; bf16_t* merged;
    __device__ __forceinline__ void operator()(const f32x4 (&acc)[2][2][4][2], const Unit& u, int wr, int wc, int fr, int fq) const {
        const int row0 = u.pm * BM + wr * 64 + fr, col0 = u.pn * BM + wc * 32 + 8 * fq;
#pragma unroll
        for (int ai = 0; ai < 2; ++ai)
#pragma unroll
            for (int m = 0; m < 4; ++m) { const size_t r = (size_t)(row0 + ai * HALF + m * 16);
#pragma unroll
                for (int bj = 0; bj < 2; ++bj) { const int c = col0 + bj * HALF;
                    const u32x4 gw = *(const u32x4*)(G + r * 3072 + gofs + c);
                    f32x4 v0 = acc[ai][bj][m][0], v1 = acc[ai][bj][m][1];
                    v0[0] *= bf_lo(gw.x); v0[1] *= bf_hi(gw.x); v0[2] *= bf_lo(gw.y); v0[3] *= bf_hi(gw.y); v1[0] *= bf_lo(gw.z); v1[1] *= bf_hi(gw.z); v1[2] *= bf_lo(gw.w); v1[3] *= bf_hi(gw.w);
                    u32x4* mp = (u32x4*)(merged + r * 1024 + c);
                    if (MODE >= 1) { const u32x4 pw = *mp; v0[0] += bf_lo(pw.x); v0[1] += bf_hi(pw.x); v0[2] += bf_lo(pw.y); v0[3] += bf_hi(pw.y); v1[0] += bf_lo(pw.z); v1[1] += bf_hi(pw.z); v1[2] += bf_lo(pw.w); v1[3] += bf_hi(pw.w); }
                    u32x4 w; w.x = cvt_pk_bf16(v0[0], v0[1]); w.y = cvt_pk_bf16(v0[2], v0[3]); w.z = cvt_pk_bf16(v1[0], v1[1]); w.w = cvt_pk_bf16(v1[2], v1[3]);
                    *mp = w; } }
    }
};
struct EpiRes {
    static constexpr bool PERM = false, AFTER_DRAIN = false;
    const float* base; float* out;
    __device__ __forceinline__ void operator()(const f32x4 (&acc)[2][2][4][2], const Unit& u, int wr, int wc, int fr, int fq) const {
#pragma unroll
        for (int ai = 0; ai < 2; ++ai)
#pragma unroll
            for (int m = 0; m < 4; ++m) { const size_t r = (size_t)(u.pm * BM + ai * HALF + wr * 64 + m * 16 + fr);
#pragma unroll
                for (int bj = 0; bj < 2; ++bj)
#pragma unroll
                    for (int n = 0; n < 2; ++n) { const int c = u.pn * BM + bj * HALF + wc * 32 + n * 16 + 4 * fq;
                        const f32x4 bs = *(const f32x4*)(base + r * 1024 + c); *(f32x4*)(out + r * 1024 + c) = bs + acc[ai][bj][m][n]; } }
    }
};
template <class Epi, class Sched, bool ALIGN_EPI = false, bool SP2 = false>
__device__ __forceinline__ void gemm_phase(PG8_LAS unsigned char* lds, const Gemm g, const Sched& S, const Epi& E) {
    int tid_l = threadIdx.x; asm volatile("" : "+v"(tid_l));
    const int tid = tid_l, wid = __builtin_amdgcn_readfirstlane(tid >> 6), lane = tid & 63, wr = wid >> 2, wc = wid & 3, fr = lane & 15, fq = lane >> 4;
    const int K = g.K, nt = K / BK;
    unsigned voffA[2], voffB[2];
#pragma unroll
    for (int i = 0; i < 2; ++i) { int R, C; stage_rc(tid * 16 + i * 8192, R, C); const int Rb = Epi::PERM ? ((R & ~31) + perm32(R & 31)) : R;
        voffA[i] = (unsigned)(R * K + C) * 2u; voffB[i] = (unsigned)(Rb * K + C) * 2u; }
    const size_t kstep = (size_t)(BK * 2);
    const size_t hstep = (size_t)HALF * K * 2;
    const size_t tstep = 2 * hstep;
    const unsigned ldsw = (unsigned)wid * 1024u;
    const int aoff = lds_byte(wr * 64 + fr, fq * 8), boff = lds_byte(wc * 32 + fr, fq * 8);
#define PG8_SA(b, h) (((b) * 2 + (h)) * HTB)
#define PG8_SB(b, h) ((4 + (b) * 2 + (h)) * HTB)
#define PG8_STAGE(bufoff, gbase, voff) do { _Pragma("unroll") for (int _i = 0; _i < 2; ++_i) \
        __builtin_amdgcn_global_load_lds((const unsigned*)((const char*)(gbase) + (voff)[_i]), (PG8_LAS unsigned*)(lds + (bufoff) + ldsw + _i * 8192), 16, 0, 0); } while (0)
#define PG8_LDA(dst, b, h) do { _Pragma("unroll") for (int m = 0; m < 4; ++m) _Pragma("unroll") for (int k = 0; k < 2; ++k) dst[m][k] = *(const PG8_LAS bf16x8*)(lds + PG8_SA(b, h) + aoff + m * 2048 + k * 1024); } while (0)
#define PG8_LDB(dst, b, h) do { _Pragma("unroll") for (int n = 0; n < 2; ++n) _Pragma("unroll") for (int k = 0; k < 2; ++k) dst[n][k] = *(const PG8_LAS bf16x8*)(lds + PG8_SB(b, h) + boff + n * 2048 + k * 1024); } while (0)
#define PG8_MMA(ai, bj, At, Bt) do { __builtin_amdgcn_s_setprio(1); _Pragma("unroll") for (int m = 0; m < 4; ++m) _Pragma("unroll") for (int n = 0; n < 2; ++n) _Pragma("unroll") for (int k = 0; k < 2; ++k) \
        acc[ai][bj][m][n] = __builtin_amdgcn_mfma_f32_16x16x32_bf16(Bt[n][k], At[m][k], acc[ai][bj][m][n], 0, 0, 0); __builtin_amdgcn_s_setprio(0); } while (0)
#define PG8_WAIT_V(n) asm volatile("s_waitcnt vmcnt(" #n ")" ::: "memory")
#define PG8_WAIT_L(n) asm volatile("s_waitcnt lgkmcnt(" #n ")" ::: "memory")
#define PG8_BAR __builtin_amdgcn_s_barrier()
#define PG8_SCHED __builtin_amdgcn_sched_barrier(0)
    Unit cur, nxt; int ui = 0;
    if (!S.next(0, cur)) return;
    f32x4 acc[2][2][4][2];
#pragma unroll
    for (int a = 0; a < 2; ++a)
#pragma unroll
        for (int b = 0; b < 2; ++b)
#pragma unroll
            for (int m = 0; m < 4; ++m)
#pragma unroll
                for (int n = 0; n < 2; ++n) acc[a][b][m][n] = (f32x4){0.f, 0.f, 0.f, 0.f};
    bf16x8 At[4][2], B0[2][2], B1[2][2];
    const char* cA = (const char*)g.A + (size_t)cur.pm * tstep; const char* cB = (const char*)g.Bt + (size_t)cur.pn * tstep;
    S.a_ready(cur);
    if constexpr (SP2) {
        PG8_STAGE(PG8_SB(0, 0), cB, voffB); PG8_STAGE(PG8_SB(0, 1), cB + hstep, voffB); PG8_STAGE(PG8_SA(0, 0), cA, voffA); PG8_STAGE(PG8_SA(0, 1), cA + hstep, voffA);
        if (wr == 1) PG8_BAR;
        PG8_WAIT_V(2); PG8_BAR;
        PG8_STAGE(PG8_SB(1, 0), cB + kstep, voffB); PG8_STAGE(PG8_SA(1, 0), cA + kstep, voffA); PG8_STAGE(PG8_SB(1, 1), cB + hstep + kstep, voffB);
        PG8_WAIT_V(6); PG8_BAR;
    } else {
        PG8_STAGE(PG8_SB(0, 0), cB, voffB); PG8_STAGE(PG8_SA(0, 0), cA, voffA); PG8_STAGE(PG8_SB(0, 1), cB + hstep, voffB); PG8_STAGE(PG8_SA(0, 1), cA + hstep, voffA);
        if (wr == 1) PG8_BAR;
        PG8_WAIT_V(4); PG8_BAR;
        PG8_STAGE(PG8_SB(1, 0), cB + kstep, voffB); PG8_STAGE(PG8_SA(1, 0), cA + kstep, voffA); PG8_STAGE(PG8_SB(1, 1), cB + hstep + kstep, voffB);
        PG8_WAIT_V(6); PG8_BAR;
    }
    for (;;) {
        const bool has_next = S.next(ui + 1, nxt);
        const char* nA = has_next ? (const char*)g.A + (size_t)nxt.pm * tstep : cA; const char* nB = has_next ? (const char*)g.Bt + (size_t)nxt.pn * tstep : cB;
        for (int t = 0; t < nt; t += 2) {
            const bool last = (t == nt - 2);
            const char* a1 = cA + (size_t)(t + 1) * kstep;
            const char* a2 = last ? nA : cA + (size_t)(t + 2) * kstep; const char* b2 = last ? nB : cB + (size_t)(t + 2) * kstep;
            const char* a3 = a2 + kstep; const char* b3 = b2 + kstep;
            if (last && has_next) S.a_ready(nxt);
            if constexpr (SP2) {
            PG8_LDB(B0, 0, 0); PG8_LDB(B1, 0, 1); PG8_SCHED; PG8_LDA(At, 0, 0); PG8_STAGE(PG8_SA(1, 1), a1 + hstep, voffA);
            PG8_WAIT_V(8); PG8_WAIT_L(0); PG8_BAR; PG8_MMA(0, 0, At, B0); PG8_MMA(0, 1, At, B1); PG8_BAR; PG8_SCHED;
            PG8_LDA(At, 0, 1); PG8_STAGE(PG8_SB(0, 0), b2, voffB); PG8_STAGE(PG8_SB(0, 1), b2 + hstep, voffB); PG8_STAGE(PG8_SA(0, 0), a2, voffA);
            PG8_WAIT_V(8); PG8_WAIT_L(0); PG8_BAR; PG8_MMA(1, 0, At, B0); PG8_MMA(1, 1, At, B1); PG8_BAR; PG8_SCHED;
            PG8_LDB(B0, 1, 0); PG8_LDB(B1, 1, 1); PG8_SCHED; PG8_LDA(At, 1, 0); PG8_STAGE(PG8_SA(0, 1), a2 + hstep, voffA);
            PG8_WAIT_V(8); PG8_WAIT_L(0); PG8_BAR; PG8_MMA(0, 0, At, B0); PG8_MMA(0, 1, At, B1); PG8_BAR; PG8_SCHED;
            PG8_LDA(At, 1, 1); PG8_STAGE(PG8_SB(1, 0), b3, voffB); PG8_STAGE(PG8_SB(1, 1), b3 + hstep, voffB); PG8_STAGE(PG8_SA(1, 0), a3, voffA);
            PG8_WAIT_V(8); PG8_WAIT_L(0); PG8_BAR; PG8_MMA(1, 0, At, B0); PG8_MMA(1, 1, At, B1); PG8_BAR; PG8_SCHED;
            } else {
            PG8_LDB(B0, 0, 0); PG8_SCHED; PG8_LDA(At, 0, 0); PG8_STAGE(PG8_SA(1, 1), a1 + hstep, voffA);
            PG8_WAIT_L(8); PG8_BAR; PG8_WAIT_L(0); PG8_MMA(0, 0, At, B0); PG8_BAR; PG8_SCHED;
            PG8_LDB(B1, 0, 1); PG8_STAGE(PG8_SB(0, 0), b2, voffB);
            PG8_BAR; PG8_WAIT_L(0); PG8_MMA(0, 1, At, B1); PG8_BAR;
            PG8_LDA(At, 0, 1); PG8_STAGE(PG8_SA(0, 0), a2, voffA);
            PG8_BAR; PG8_WAIT_L(0); PG8_MMA(1, 0, At, B0); PG8_BAR; PG8_SCHED;
            PG8_STAGE(PG8_SB(0, 1), b2 + hstep, voffB);
            PG8_WAIT_V(6); PG8_BAR; PG8_MMA(1, 1, At, B1); PG8_BAR;
            PG8_LDB(B0, 1, 0); PG8_SCHED; PG8_LDA(At, 1, 0); PG8_STAGE(PG8_SA(0, 1), a2 + hstep, voffA);
            PG8_WAIT_L(8); PG8_BAR; PG8_WAIT_L(0); PG8_MMA(0, 0, At, B0); PG8_BAR; PG8_SCHED;
            PG8_LDB(B1, 1, 1); PG8_STAGE(PG8_SB(1, 0), b3, voffB);
            PG8_BAR; PG8_WAIT_L(0); PG8_MMA(0, 1, At, B1); PG8_BAR;
            PG8_LDA(At, 1, 1); PG8_STAGE(PG8_SA(1, 0), a3, voffA);
            PG8_BAR; PG8_WAIT_L(0); PG8_MMA(1, 0, At, B0); PG8_BAR; PG8_SCHED;
            PG8_STAGE(PG8_SB(1, 1), b3 + hstep, voffB);
            PG8_WAIT_V(6); PG8_BAR; PG8_MMA(1, 1, At, B1); PG8_BAR;
            }
        }
        if constexpr (ALIGN_EPI) { if (wr == 0) PG8_BAR; }
        if constexpr (!Epi::AFTER_DRAIN) { E(acc, cur, wr, wc, fr, fq); S.done(cur); }
        if (!has_next) break;
#pragma unroll
        for (int a = 0; a < 2; ++a)
#pragma unroll
            for (int b = 0; b < 2; ++b)
#pragma unroll
                for (int m = 0; m < 4; ++m)
#pragma unroll
                    for (int n = 0; n < 2; ++n) acc[a][b][m][n] = (f32x4){0.f, 0.f, 0.f, 0.f};
        cur = nxt; cA = nA; cB = nB; ++ui;
        if constexpr (ALIGN_EPI) { if (wr == 1) PG8_BAR; }
    }
    PG8_WAIT_V(0);
    if constexpr (!ALIGN_EPI) { if (wr == 0) PG8_BAR; }
    PG8_BAR;
    if constexpr (Epi::AFTER_DRAIN) { E.fused(acc, cur, wr, wc, fr, fq, lds, wid, lane); S.done(cur); }
#undef PG8_SA
#undef PG8_SB
#undef PG8_STAGE
#undef PG8_LDA
#undef PG8_LDB
#undef PG8_MMA
#undef PG8_WAIT_V
#undef PG8_WAIT_L
#undef PG8_BAR
#undef PG8_SCHED
}
}

#define LAS __attribute__((address_space(3)))
typedef unsigned short bf16;
typedef unsigned u32x4 __attribute__((ext_vector_type(4)));
typedef unsigned u32x2 __attribute__((ext_vector_type(2)));
typedef float f32x4 __attribute__((ext_vector_type(4)));
typedef float f32x16 __attribute__((ext_vector_type(16)));
typedef float f32x2 __attribute__((ext_vector_type(2)));
typedef short bf16x8 __attribute__((ext_vector_type(8)));
constexpr int NWAVES = 8;
constexpr int BATCH = 8, SEQ = 8192, DM = 1024, MTOK = BATCH * SEQ, FF = 4096, MEML = 256, MROWS = BATCH * MEML;
constexpr int IN_COLS = 5704, NQ = 2816, NG = 3072, NPROJ = NQ + NG;
constexpr int C_QA = 0, C_KA = 384, C_VA = 768, C_QB = 1152, C_KB = 1536, C_VB = 1664, C_QI = 1792, C_KI = 2304, C_WI = 2368, C_QC = 2376, C_GATE = 2632;
constexpr float EPS = 1e-6f;
constexpr size_t MiB = 1u << 20;
constexpr size_t WS_WIN = 0, WS_WMEM = 12 * MiB, WS_WA = 13 * MiB, WS_WB = 13 * MiB + 256 * 1024, WS_WC = 14 * MiB, WS_WO = 15 * MiB, WS_W1 = 17 * MiB, WS_W2 = 25 * MiB;
constexpr size_t WS_HM = 33 * MiB, WS_MKV = 37 * MiB, WS_H = 40 * MiB, WS_OA = 40 * MiB, WS_OB = 56 * MiB, WS_OC = 104 * MiB;
constexpr size_t WS_CTL = 39 * MiB, CTL_BYTES = 16384;
constexpr size_t WS_LISTS = 136 * MiB;
constexpr size_t WS_PQ = 168 * MiB, WS_G = 520 * MiB, WS_HID = 168 * MiB, WS_MERGED = 168 * MiB, WS_KIF = 904 * MiB, WS_CNT = 912 * MiB, WS_END = 913 * MiB;
constexpr int LDS_BYTES = 159744;
#define LDS_WAIT() asm volatile("s_waitcnt lgkmcnt(0)" ::: "memory")
#define LDS_ORDER() asm volatile("" ::: "memory")
#define MFMA32(a, b, c) __builtin_amdgcn_mfma_f32_32x32x16_bf16((a), (b), (c), 0, 0, 0)

__device__ __forceinline__ unsigned f2bf(float f) { unsigned u = __builtin_bit_cast(unsigned, f); return (u + 0x7fffu + ((u >> 16) & 1u)) >> 16; }
__device__ __forceinline__ unsigned pk2(float lo, float hi) { return f2bf(lo) | (f2bf(hi) << 16); }
__device__ __forceinline__ float bf2f(unsigned short h) { return __uint_as_float(((unsigned)h) << 16); }
__device__ __forceinline__ float wlo(unsigned w) { return __uint_as_float(w << 16); }
__device__ __forceinline__ float whi(unsigned w) { return __uint_as_float(w & 0xffff0000u); }
__device__ __forceinline__ int crow(int reg, int h) { return (reg & 3) + 8 * (reg >> 2) + 4 * h; }
__device__ __forceinline__ float wave_sum(float v) {
#pragma unroll
    for (int o = 1; o < 64; o <<= 1) v += __shfl_xor(v, o);
    return v;
}
__device__ __forceinline__ float wave_min(float v) {
#pragma unroll
    for (int o = 1; o < 64; o <<= 1) v = fminf(v, __shfl_xor(v, o));
    return v;
}
__device__ __forceinline__ float wave_max(float v) {
#pragma unroll
    for (int o = 1; o < 64; o <<= 1) v = fmaxf(v, __shfl_xor(v, o));
    return v;
}
__device__ __forceinline__ bf16x8 pack8(float a0, float a1, float a2, float a3, float a4, float a5, float a6, float a7) {
    u32x4 p; p.x = pk2(a0, a1); p.y = pk2(a2, a3); p.z = pk2(a4, a5); p.w = pk2(a6, a7); return __builtin_bit_cast(bf16x8, p);
}

__device__ __forceinline__ void transpose_item(const float* W, int K, int ldw, int c0, int nvalid, bf16* WT, int r0, int nblk, LAS float* scr, int item, int lane) {
    const int kb = item / nblk, nb = item % nblk, k0 = 64 * kb, n0 = 32 * nb;
    const int nn = n0 + (lane & 31); const bool ok = nn < nvalid;
#pragma unroll 8
    for (int i = 0; i < 32; ++i) { const int kk = 2 * i + (lane >> 5); scr[kk * 33 + (lane & 31)] = ok ? W[(size_t)(k0 + kk) * ldw + c0 + nn] : 0.f; }
    LDS_WAIT();
    const int c = lane & 7;
#pragma unroll
    for (int j = 0; j < 4; ++j) { const int n = (lane >> 3) + 8 * j; const LAS float* s = scr + (8 * c) * 33 + n;
        u32x4 o; o.x = pk2(s[0 * 33], s[1 * 33]); o.y = pk2(s[2 * 33], s[3 * 33]); o.z = pk2(s[4 * 33], s[5 * 33]); o.w = pk2(s[6 * 33], s[7 * 33]);
        *(u32x4*)(WT + (size_t)(r0 + n0 + n) * K + k0 + 8 * c) = o; }
    LDS_WAIT();
}
__device__ __forceinline__ void rms_row_to_bf16(const float* xrow, const float* g, bf16* orow, int lane) {
    const f32x4* xr = (const f32x4*)xrow + lane; const f32x4* gr = (const f32x4*)g + lane;
    f32x4 v[4]; float s = 0.f;
#pragma unroll
    for (int j = 0; j < 4; ++j) { v[j] = xr[64 * j]; s += (v[j].x * v[j].x + v[j].y * v[j].y) + (v[j].z * v[j].z + v[j].w * v[j].w); }
    const float rs = 1.0f / sqrtf(wave_sum(s) * (1.0f / 1024.0f) + EPS);
    u32x2* o8 = (u32x2*)orow + lane;
#pragma unroll
    for (int j = 0; j < 4; ++j) { const f32x4 gg = gr[64 * j]; u32x2 w; w.x = pk2(v[j].x * rs * gg.x, v[j].y * rs * gg.y); w.y = pk2(v[j].z * rs * gg.z, v[j].w * rs * gg.w); o8[64 * j] = w; }
}

struct Args { const float* in[20]; float* out; unsigned char* ws; int ph_lo, ph_hi; };
typedef const __attribute__((address_space(4))) Args* KArgs;

__device__ __forceinline__ void p0_prologue(KArgs a, LAS unsigned char* lds, int gw, int NGW, int wave, int lane) {
    LAS float* scr = (LAS float*)(lds + wave * 16384);
    unsigned char* ws = a->ws;
    constexpr int I0 = 16 * 88, I1 = 16 * 96, I2 = 16 * 16, I3 = 2 * 32, I4 = 6 * 32, I5 = 4 * 32, I6 = 16 * 32, I7 = 16 * 128, I8 = 64 * 32;
    constexpr int NITEMS = I0 + I1 + I2 + I3 + I4 + I5 + I6 + I7 + I8;
    for (int it = gw; it < NITEMS; it += NGW) {
        int r = it;
        if (r < I0) { transpose_item(a->in[5], 1024, IN_COLS, 0, C_GATE, (bf16*)(ws + WS_WIN), 0, 88, scr, r, lane); continue; } r -= I0;
        if (r < I1) { transpose_item(a->in[5], 1024, IN_COLS, C_GATE, NG, (bf16*)(ws + WS_WIN), NQ, 96, scr, r, lane); continue; } r -= I1;
        if (r < I2) { transpose_item(a->in[12], 1024, 512, 0, 512, (bf16*)(ws + WS_WMEM), 0, 16, scr, r, lane); continue; } r -= I2;
        if (r < I3) { transpose_item(a->in[13], 128, 1024, 0, 1024, (bf16*)(ws + WS_WA), 0, 32, scr, r, lane); continue; } r -= I3;
        if (r < I4) { transpose_item(a->in[14], 384, 1024, 0, 1024, (bf16*)(ws + WS_WB), 0, 32, scr, r, lane); continue; } r -= I4;
        if (r < I5) { transpose_item(a->in[15], 256, 1024, 0, 1024, (bf16*)(ws + WS_WC), 0, 32, scr, r, lane); continue; } r -= I5;
        if (r < I6) { transpose_item(a->in[16], 1024, 1024, 0, 1024, (bf16*)(ws + WS_WO), 0, 32, scr, r, lane); continue; } r -= I6;
        if (r < I7) { transpose_item(a->in[18], 1024, FF, 0, FF, (bf16*)(ws + WS_W1), 0, 128, scr, r, lane); continue; } r -= I7;
        transpose_item(a->in[19], FF, 1024, 0, 1024, (bf16*)(ws + WS_W2), 0, 32, scr, r, lane);
    }
    for (int m = gw; m < MTOK; m += NGW) rms_row_to_bf16(a->in[0] + (size_t)m * DM, a->in[3], (bf16*)(ws + WS_H) + (size_t)m * DM, lane);
    for (int m = gw; m < MROWS; m += NGW) rms_row_to_bf16(a->in[1] + (size_t)m * DM, a->in[4], (bf16*)(ws + WS_HM) + (size_t)m * DM, lane);
}

__device__ __forceinline__ void p2_normrot(KArgs a, int gw, int NGW, int lane) {
    bf16* Pq = (bf16*)(a->ws + WS_PQ); bf16* KIF = (bf16*)(a->ws + WS_KIF);
    const int* positions = (const int*)a->in[2];
    const int sub = lane & 7;
    int col0[5]; const float* gp[5]; bool rotf[5], actf[5];
#pragma unroll
    for (int rnd = 0; rnd < 5; ++rnd) {
        const int slot0 = rnd * 8 + (lane >> 3); actf[rnd] = slot0 < 33; const int s = actf[rnd] ? slot0 : 32;
        if (s < 6) { col0[rnd] = C_QA + 64 * s; gp[rnd] = a->in[6]; rotf[rnd] = true; }
        else if (s < 12) { col0[rnd] = C_KA + 64 * (s - 6); gp[rnd] = a->in[7]; rotf[rnd] = true; }
        else if (s < 18) { col0[rnd] = C_QB + 64 * (s - 12); gp[rnd] = a->in[8]; rotf[rnd] = true; }
        else if (s < 20) { col0[rnd] = C_KB + 64 * (s - 18); gp[rnd] = a->in[9]; rotf[rnd] = true; }
        else if (s < 28) { col0[rnd] = C_QI + 64 * (s - 20); gp[rnd] = nullptr; rotf[rnd] = true; }
        else if (s < 29) { col0[rnd] = C_KI; gp[rnd] = nullptr; rotf[rnd] = true; }
        else { col0[rnd] = C_QC + 64 * (s - 29); gp[rnd] = a->in[10]; rotf[rnd] = false; }
        col0[rnd] += 8 * sub;
    }
    u32x4 rawC[5], rawN[5]; int posC, posN;
    {
        const int t0_ = gw < MTOK ? gw : MTOK - 1;
#pragma unroll
        for (int rnd = 0; rnd < 5; ++rnd) rawC[rnd] = *(const u32x4*)(Pq + (size_t)t0_ * NQ + col0[rnd]);
        posC = positions[t0_];
    }
#pragma unroll 1
    for (int tok = gw; tok < MTOK; tok += NGW) {
        {
            const int tn = tok + NGW < MTOK ? tok + NGW : MTOK - 1;
#pragma unroll
            for (int rnd = 0; rnd < 5; ++rnd) rawN[rnd] = *(const u32x4*)(Pq + (size_t)tn * NQ + col0[rnd]);
            posN = positions[tn];
        }
        const float inv = __builtin_amdgcn_exp2f(-(float)sub * 2.3664460711f);
        const float ang = (float)posC * inv;
        const double rev = (double)ang * 0.15915494309189535; const float fr = (float)(rev - floor(rev));
        const float cs = __builtin_amdgcn_cosf(fr), sn = __builtin_amdgcn_sinf(fr);
        float ce[8], se[8];
#pragma unroll
        for (int e = 0; e < 8; ++e) { ce[e] = __shfl(cs, e); se[e] = __shfl(sn, e); }
        bf16* row = Pq + (size_t)tok * NQ;
#pragma unroll
        for (int rnd = 0; rnd < 5; ++rnd) {
            const u32x4 raw = rawC[rnd];
            float v[8] = {wlo(raw.x), whi(raw.x), wlo(raw.y), whi(raw.y), wlo(raw.z), whi(raw.z), wlo(raw.w), whi(raw.w)};
            float ss = 0.f;
#pragma unroll
            for (int e = 0; e < 8; ++e) ss += v[e] * v[e];
            ss += __shfl_xor(ss, 1); ss += __shfl_xor(ss, 2); ss += __shfl_xor(ss, 4);
            const float* g = gp[rnd];
            if (g) { const float rs = 1.0f / sqrtf(ss * (1.0f / 64.0f) + EPS); const f32x4 g0 = *(const f32x4*)(g + 8 * sub), g1 = *(const f32x4*)(g + 8 * sub + 4);
                v[0] *= rs * g0.x; v[1] *= rs * g0.y; v[2] *= rs * g0.z; v[3] *= rs * g0.w; v[4] *= rs * g1.x; v[5] *= rs * g1.y; v[6] *= rs * g1.z; v[7] *= rs * g1.w; }
            float ot[8];
#pragma unroll
            for (int e = 0; e < 8; ++e) ot[e] = __shfl_xor(v[e], 1);
            if (rotf[rnd] && sub < 2) {
                const float sg = sub == 0 ? -1.f : 1.f;
#pragma unroll
                for (int e = 0; e < 8; ++e) v[e] = v[e] * ce[e] + sg * ot[e] * se[e];
            }
            if (actf[rnd]) { u32x4 o; o.x = pk2(v[0], v[1]); o.y = pk2(v[2], v[3]); o.z = pk2(v[4], v[5]); o.w = pk2(v[6], v[7]); *(u32x4*)(row + col0[rnd]) = o;
                if (rnd == 3 && (lane >> 3) == 4) {
                    const int tb_ = tok >> 5, n_ = tok & 31, ks_ = sub >> 1, hi_ = sub & 1;
                    *(u32x4*)(KIF + ((((size_t)tb_ * 4 + ks_) * 2 + hi_) * 32 + n_) * 8) = o; } }
        }
#pragma unroll
        for (int rnd = 0; rnd < 5; ++rnd) rawC[rnd] = rawN[rnd];
        posC = posN;
    }
    bf16* MKV = (bf16*)(a->ws + WS_MKV);
    for (int it = gw; it < MROWS / 2; it += NGW) {
        const int row = 2 * it + (lane >> 5), slot = (lane >> 3) & 3;
        u32x4* p = (u32x4*)(MKV + (size_t)row * 512 + slot * 64 + 8 * sub);
        const u32x4 raw = *p;
        float v[8] = {wlo(raw.x), whi(raw.x), wlo(raw.y), whi(raw.y), wlo(raw.z), whi(raw.z), wlo(raw.w), whi(raw.w)};
        float ss = 0.f;
#pragma unroll
        for (int e = 0; e < 8; ++e) ss += v[e] * v[e];
        ss += __shfl_xor(ss, 1); ss += __shfl_xor(ss, 2); ss += __shfl_xor(ss, 4);
        const float rs = 1.0f / sqrtf(ss * (1.0f / 64.0f) + EPS); const float* g = a->in[11];
        const f32x4 g0 = *(const f32x4*)(g + 8 * sub), g1 = *(const f32x4*)(g + 8 * sub + 4);
        u32x4 o; o.x = pk2(v[0] * rs * g0.x, v[1] * rs * g0.y); o.y = pk2(v[2] * rs * g0.z, v[3] * rs * g0.w); o.z = pk2(v[4] * rs * g1.x, v[5] * rs * g1.y); o.w = pk2(v[6] * rs * g1.z, v[7] * rs * g1.w);
        *p = o;
    }
}

typedef short s16x4e __attribute__((ext_vector_type(4)));
__device__ __forceinline__ s16x4e lds_tr16e(const LAS unsigned char* p) { return __builtin_bit_cast(s16x4e, __builtin_amdgcn_ds_read_tr16_b64_v4i16((LAS s16x4e*)p)); }
constexpr int KROWE = 144, VROWE = 192;
__device__ __forceinline__ void dilated_unit(LAS unsigned char* wl, const bf16* Pq, bf16* OA, int b, int hh, int tb, int r, int lane) {
    const int qi = lane & 31, hi = lane >> 5;
    const int r8 = lane >> 3, ch8 = lane & 7;
    LAS unsigned char* kwr = wl + r8 * KROWE + ch8 * 16; LAS unsigned char* vwr = wl + 4608 + r8 * VROWE + ch8 * 16;
    const LAS unsigned char* krd = wl + qi * KROWE + hi * 16;
    const LAS unsigned char* vrd = wl + 4608 + (4 * hi + ((lane & 15) >> 2)) * VROWE + (((lane >> 4) & 1) * 16 + 4 * (lane & 3)) * 2;
    const int t_q = tb * 512 + r + 16 * qi;
    const size_t rowb = (size_t)b * SEQ;
    f32x16 o0, o1;
#pragma unroll
    for (int i = 0; i < 16; ++i) { o0[i] = 0.f; o1[i] = 0.f; }
    float l = 0.f;
#pragma unroll 1
    for (int g = 0; g < 3; ++g) {
        const int dl = 2 * g, dil = 1 << dl, rho = r & (dil - 1), head = 2 * g + hh;
        const int step = 16 >> dl, m_q = t_q >> dl, m0 = (tb * 512 + r) >> dl, kstart = m0 - 128, mmax = (SEQ >> dl) - 1;
        const int nblk = (129 + 31 * step + 31) >> 5;
        bf16x8 qf[4];
#pragma unroll
        for (int ks = 0; ks < 4; ++ks) qf[ks] = *(const bf16x8*)(Pq + (rowb + t_q) * NQ + C_QA + head * 64 + 16 * ks + 8 * hi);
        u32x4 kgA[4], kgB[4], vgA[4], vgB[4];
#define DL_LOAD(kg_, vg_, kb_) do { const int kbase_ = kstart + 32 * (kb_); \
            _Pragma("unroll") for (int i = 0; i < 4; ++i) { int mk_ = kbase_ + 8 * i + r8; mk_ = mk_ < 0 ? 0 : (mk_ > mmax ? mmax : mk_); \
                const bf16* row_ = Pq + (rowb + ((size_t)mk_ << dl) + rho) * NQ + head * 64 + ch8 * 8; \
                kg_[i] = *(const u32x4*)(row_ + C_KA); vg_[i] = *(const u32x4*)(row_ + C_VA); } } while (0)
#define DL_COMP(kg_, vg_, kb_) do { const int kbase_ = kstart + 32 * (kb_); \
            _Pragma("unroll") for (int i = 0; i < 4; ++i) { *(LAS u32x4*)(kwr + 8 * i * KROWE) = kg_[i]; *(LAS u32x4*)(vwr + 8 * i * VROWE) = vg_[i]; } \
            LDS_ORDER(); \
            f32x16 s_; \
            _Pragma("unroll") for (int i = 0; i < 16; ++i) s_[i] = 0.f; \
            _Pragma("unroll") for (int ks = 0; ks < 4; ++ks) { const bf16x8 kf_ = *(const LAS bf16x8*)(krd + ks * 32); s_ = MFMA32(kf_, qf[ks], s_); } \
            float p_[16]; \
            _Pragma("unroll") for (int i = 0; i < 16; ++i) { const int mka = kbase_ + crow(i, hi); const int dist = m_q - mka; const bool ok = (dist >= 0) && (dist <= 128) && (mka >= 0); \
                p_[i] = ok ? __expf(s_[i] * 0.125f) : 0.f; l += p_[i]; } \
            _Pragma("unroll") for (int st = 0; st < 2; ++st) { \
                const bf16x8 pb = pack8(p_[8 * st + 0], p_[8 * st + 1], p_[8 * st + 2], p_[8 * st + 3], p_[8 * st + 4], p_[8 * st + 5], p_[8 * st + 6], p_[8 * st + 7]); \
                const s16x4e l0_ = lds_tr16e(vrd + st * 16 * VROWE), h0_ = lds_tr16e(vrd + (st * 16 + 8) * VROWE), l1_ = lds_tr16e(vrd + st * 16 * VROWE + 64), h1_ = lds_tr16e(vrd + (st * 16 + 8) * VROWE + 64); \
                o0 = MFMA32(((bf16x8){l0_[0], l0_[1], l0_[2], l0_[3], h0_[0], h0_[1], h0_[2], h0_[3]}), pb, o0); \
                o1 = MFMA32(((bf16x8){l1_[0], l1_[1], l1_[2], l1_[3], h1_[0], h1_[1], h1_[2], h1_[3]}), pb, o1); } \
            LDS_ORDER(); } while (0)
        const int lastk = nblk - 1;
        DL_LOAD(kgA, vgA, 0);
#pragma unroll 1
        for (int kb = 0; kb < nblk; kb += 2) {
            DL_LOAD(kgB, vgB, (kb + 1 < lastk ? kb + 1 : lastk));
            DL_COMP(kgA, vgA, kb);
            DL_LOAD(kgA, vgA, (kb + 2 < lastk ? kb + 2 : lastk));
            if (kb + 1 < nblk) DL_COMP(kgB, vgB, kb + 1);
        }
#undef DL_LOAD
#undef DL_COMP
    }
    l += __shfl_xor(l, 32);
    const float inv = 1.0f / l;
    bf16* orow = OA + (rowb + t_q) * 128 + hh * 64;
#pragma unroll
    for (int g4 = 0; g4 < 4; ++g4) {
        u32x2 w0, w1; w0.x = pk2(o0[4 * g4] * inv, o0[4 * g4 + 1] * inv); w0.y = pk2(o0[4 * g4 + 2] * inv, o0[4 * g4 + 3] * inv);
        w1.x = pk2(o1[4 * g4] * inv, o1[4 * g4 + 1] * inv); w1.y = pk2(o1[4 * g4 + 2] * inv, o1[4 * g4 + 3] * inv);
        *(u32x2*)(orow + 8 * g4 + 4 * hi) = w0; *(u32x2*)(orow + 32 + 8 * g4 + 4 * hi) = w1;
    }
}

__device__ __forceinline__ void mem_unit(LAS unsigned char* wl, const bf16* Pq, const bf16* MKV, bf16* OC, int b, int head, int qb, int lane) {
    const int qi = lane & 31, hi = lane >> 5;
    const int r8 = lane >> 3, ch8 = lane & 7;
    LAS unsigned char* kwr = wl + r8 * KROWE + ch8 * 16; LAS unsigned char* vwr = wl + 4608 + r8 * VROWE + ch8 * 16;
    const LAS unsigned char* krd = wl + qi * KROWE + hi * 16;
    const LAS unsigned char* vrd = wl + 4608 + (4 * hi + ((lane & 15) >> 2)) * VROWE + (((lane >> 4) & 1) * 16 + 4 * (lane & 3)) * 2;
    const size_t tokrow = (size_t)b * SEQ + qb * 32 + qi;
    bf16x8 qf[4];
#pragma unroll
    for (int ks = 0; ks < 4; ++ks) qf[ks] = *(const bf16x8*)(Pq + tokrow * NQ + C_QC + head * 64 + 16 * ks + 8 * hi);
    f32x16 o0, o1;
#pragma unroll
    for (int i = 0; i < 16; ++i) { o0[i] = 0.f; o1[i] = 0.f; }
    float l = 0.f;
    const bf16* Mb = MKV + (size_t)b * MEML * 512;
    u32x4 kgA[4], kgB[4], vgA[4], vgB[4];
#define MM_LOAD(kg_, vg_, kb_) do { _Pragma("unroll") for (int i = 0; i < 4; ++i) { const bf16* row_ = Mb + (size_t)(32 * (kb_) + 8 * i + r8) * 512 + head * 64 + ch8 * 8; \
        kg_[i] = *(const u32x4*)(row_); vg_[i] = *(const u32x4*)(row_ + 256); } } while (0)
#define MM_COMP(kg_, vg_) do { \
        _Pragma("unroll") for (int i = 0; i < 4; ++i) { *(LAS u32x4*)(kwr + 8 * i * KROWE) = kg_[i]; *(LAS u32x4*)(vwr + 8 * i * VROWE) = vg_[i]; } \
        LDS_ORDER(); \
        f32x16 s_; \
        _Pragma("unroll") for (int i = 0; i < 16; ++i) s_[i] = 0.f; \
        _Pragma("unroll") for (int ks = 0; ks < 4; ++ks) { const bf16x8 kf_ = *(const LAS bf16x8*)(krd + ks * 32); s_ = MFMA32(kf_, qf[ks], s_); } \
        float p_[16]; \
        _Pragma("unroll") for (int i = 0; i < 16; ++i) { p_[i] = __expf(s_[i] * 0.125f); l += p_[i]; } \
        _Pragma("unroll") for (int st = 0; st < 2; ++st) { \
            const bf16x8 pb = pack8(p_[8 * st + 0], p_[8 * st + 1], p_[8 * st + 2], p_[8 * st + 3], p_[8 * st + 4], p_[8 * st + 5], p_[8 * st + 6], p_[8 * st + 7]); \
            const s16x4e l0_ = lds_tr16e(vrd + st * 16 * VROWE), h0_ = lds_tr16e(vrd + (st * 16 + 8) * VROWE), l1_ = lds_tr16e(vrd + st * 16 * VROWE + 64), h1_ = lds_tr16e(vrd + (st * 16 + 8) * VROWE + 64); \
            o0 = MFMA32(((bf16x8){l0_[0], l0_[1], l0_[2], l0_[3], h0_[0], h0_[1], h0_[2], h0_[3]}), pb, o0); \
            o1 = MFMA32(((bf16x8){l1_[0], l1_[1], l1_[2], l1_[3], h1_[0], h1_[1], h1_[2], h1_[3]}), pb, o1); } \
        LDS_ORDER(); } while (0)
    MM_LOAD(kgA, vgA, 0);
#pragma unroll 1
    for (int kb = 0; kb < 8; kb += 2) {
        MM_LOAD(kgB, vgB, kb + 1);
        MM_COMP(kgA, vgA);
        MM_LOAD(kgA, vgA, (kb + 2 < 7 ? kb + 2 : 7));
        MM_COMP(kgB, vgB);
    }
#undef MM_LOAD
#undef MM_COMP
    l += __shfl_xor(l, 32);
    const float inv = 1.0f / l;
    bf16* orow = OC + tokrow * 256 + head * 64;
#pragma unroll
    for (int g4 = 0; g4 < 4; ++g4) {
        u32x2 w0, w1; w0.x = pk2(o0[4 * g4] * inv, o0[4 * g4 + 1] * inv); w0.y = pk2(o0[4 * g4 + 2] * inv, o0[4 * g4 + 3] * inv);
        w1.x = pk2(o1[4 * g4] * inv, o1[4 * g4 + 1] * inv); w1.y = pk2(o1[4 * g4 + 2] * inv, o1[4 * g4 + 3] * inv);
        *(u32x2*)(orow + 8 * g4 + 4 * hi) = w0; *(u32x2*)(orow + 32 + 8 * g4 + 4 * hi) = w1;
    }
}

__device__ __forceinline__ int hist_find9(const LAS unsigned* h, int K, int lane, int& above_out) {
    const u32x4 ha = *(const LAS u32x4*)(h + 8 * lane), hb = *(const LAS u32x4*)(h + 8 * lane + 4);
    const int cnt[8] = {(int)ha.x, (int)ha.y, (int)ha.z, (int)ha.w, (int)hb.x, (int)hb.y, (int)hb.z, (int)hb.w};
    int tot = 0;
#pragma unroll
    for (int i = 0; i < 8; ++i) tot += cnt[i];
    int suf = tot;
#pragma unroll
    for (int off = 1; off < 64; off <<= 1) { const int t = __shfl_down(suf, off); if (lane + off < 64) suf += t; }
    const int above = suf - tot;
    const bool pred = (above < K) && (suf >= K);
    int bin = 8 * lane, abv = above, c = above; bool found = false;
#pragma unroll
    for (int i = 7; i >= 0; --i) { if (!found) { if (c + cnt[i] >= K) { bin = 8 * lane + i; abv = c; found = true; } else c += cnt[i]; } }
    const unsigned long long bal = __ballot(pred);
    const int src = bal ? (int)__ffsll((long long)bal) - 1 : 0;
    above_out = __shfl(abv, src);
    return __shfl(bin, src);
}

typedef _Float16 h16x8 __attribute__((ext_vector_type(8)));
constexpr int SB_SC = 0, SB_HIST = 131072, SB_CANDV = 147456, SB_CANDI = 151552, SB_MM = 155648;
constexpr int CCAP = 256;
__device__ __forceinline__ void dsa_select_phase(LAS unsigned char* lds, const bf16* Pq, const bf16* KIF, unsigned short* LISTS, unsigned short* CNT, int G, int bid, int wave, int lane_in) {
    LAS _Float16* sc = (LAS _Float16*)(lds + SB_SC);
    LAS unsigned* hist = (LAS unsigned*)(lds + SB_HIST);
    LAS _Float16* candv = (LAS _Float16*)(lds + SB_CANDV);
    LAS unsigned short* candi = (LAS unsigned short*)(lds + SB_CANDI);
    LAS float* mm = (LAS float*)(lds + SB_MM);
    const int q = wave;
    LAS _Float16* myS = sc + q * 8192;
    LAS unsigned* myHist = hist + q * 512;
    LAS _Float16* myCv = candv + q * CCAP; LAS unsigned short* myCi = candi + q * CCAP;
#pragma unroll 1
    for (int u = bid; u < MTOK / 8; u += G) {
        const int b = u & 7, t0 = (u >> 3) * 8;
        const size_t rowb = (size_t)b * SEQ;
        {
            int lane = lane_in; asm volatile("" : "+v"(lane));
            const int m = lane & 31, hi = lane >> 5;
            const int qq = ((m >> 2) & 1) * 2 + (m >> 4), hh = ((m >> 3) & 1) * 4 + (m & 3);
            bf16x8 qfA[4], qfB[4];
#pragma unroll
            for (int ks = 0; ks < 4; ++ks) { qfA[ks] = *(const bf16x8*)(Pq + (rowb + t0 + qq) * NQ + C_QI + hh * 64 + 16 * ks + 8 * hi); qfB[ks] = *(const bf16x8*)(Pq + (rowb + t0 + 4 + qq) * NQ + C_QI + hh * 64 + 16 * ks + 8 * hi); }
            const float WS = 0.04419417382415922f;
            f32x2 wv[4][4];
#pragma unroll
            for (int j = 0; j < 4; ++j) { const u32x4 wr_ = *(const u32x4*)(Pq + (rowb + t0 + (j >> 1) * 4 + 2 * hi + (j & 1)) * NQ + C_WI);
                wv[j][0] = (f32x2){wlo(wr_.x) * WS, whi(wr_.x) * WS}; wv[j][1] = (f32x2){wlo(wr_.y) * WS, whi(wr_.y) * WS}; wv[j][2] = (f32x2){wlo(wr_.z) * WS, whi(wr_.z) * WS}; wv[j][3] = (f32x2){wlo(wr_.w) * WS, whi(wr_.w) * WS}; }
            const int npp = (t0 + 8 + 63) >> 6;
            const bf16* kbase = KIF + (size_t)b * (SEQ * 64) + lane * 8;
            bf16x8 k0[2][4], k1[2][4];
#define SC_LOAD(buf, pp_) do { _Pragma("unroll") for (int h2 = 0; h2 < 2; ++h2) _Pragma("unroll") for (int ks = 0; ks < 4; ++ks) \
                buf[h2][ks] = *(const bf16x8*)(kbase + (size_t)((2 * (pp_) + h2) * 4 + ks) * 512); } while (0)
#define SC_TILE(qf_, j0_, qofs_, buf_, h2_) do { f32x16 acc; \
                _Pragma("unroll") for (int i = 0; i < 16; ++i) acc[i] = 0.f; \
                _Pragma("unroll") for (int ks = 0; ks < 4; ++ks) acc = MFMA32(qf_[ks], buf_[h2_][ks], acc); \
                f32x2 a0 = {0.f, 0.f}, a1 = {0.f, 0.f}; \
                _Pragma("unroll") for (int i = 0; i < 4; ++i) { \
                    const f32x2 r0 = {__builtin_amdgcn_fmed3f(acc[2 * i], 0.f, INFINITY), __builtin_amdgcn_fmed3f(acc[2 * i + 1], 0.f, INFINITY)}; \
                    const f32x2 r1 = {__builtin_amdgcn_fmed3f(acc[8 + 2 * i], 0.f, INFINITY), __builtin_amdgcn_fmed3f(acc[9 + 2 * i], 0.f, INFINITY)}; \
                    a0 = wv[j0_][i] * r0 + a0; a1 = wv[j0_ + 1][i] * r1 + a1; } \
                const _Float16 h0 = (_Float16)(a0.x + a0.y), h1 = (_Float16)(a1.x + a1.y);     \
                sc[(qofs_ + 2 * hi) * 8192 + key] = h0; sc[(qofs_ + 2 * hi + 1) * 8192 + key] = h1; } while (0)
#define SC_COMP(buf, pp_) do { _Pragma("unroll") for (int h2 = 0; h2 < 2; ++h2) { const int key = 64 * (pp_) + 32 * h2 + m; SC_TILE(qfA, 0, 0, buf, h2); SC_TILE(qfB, 2, 4, buf, h2); } } while (0)
            const int lastp = npp - 1;
            SC_LOAD(k0, (wave < lastp ? wave : lastp));
#pragma unroll 1
            for (int pp = wave; pp < npp; pp += 16) {
                SC_LOAD(k1, (pp + 8 < lastp ? pp + 8 : lastp));
                SC_COMP(k0, pp);
                SC_LOAD(k0, (pp + 16 < lastp ? pp + 16 : lastp));
                if (pp + 8 < npp) SC_COMP(k1, pp + 8);
            }
#undef SC_LOAD
#undef SC_TILE
#undef SC_COMP
            *(LAS u32x4*)(myHist + 8 * lane) = (u32x4){0u, 0u, 0u, 0u}; *(LAS u32x4*)(myHist + 8 * lane + 4) = (u32x4){0u, 0u, 0u, 0u};
        }
        __syncthreads();
        const int tq = t0 + q, nk = tq + 1;
        {
            int lane = lane_in; asm volatile("" : "+v"(lane));
            const unsigned long long lt_mask = (1ull << lane) - 1ull;
            unsigned short* drow = LISTS + (size_t)(rowb + tq) * 256;
            int nsel = 0;
            if (t0 + 8 <= 256) {
#pragma unroll 1
                for (int c = 0; c * 64 < nk; ++c) { const int e = c * 64 + lane; if (e < nk) drow[e] = (unsigned short)e; }
                nsel = nk;
            } else {
                float lo, hv;
                {
                    h16x8 vmn, vmx;
#pragma unroll
                    for (int i = 0; i < 8; ++i) { vmn[i] = (_Float16)INFINITY; vmx[i] = (_Float16)(-INFINITY); }
                    int cb = 0;
#pragma unroll 1
                    for (; cb + 512 <= nk; cb += 512) { const h16x8 v = *(const LAS h16x8*)(myS + cb + 8 * lane); vmn = __builtin_elementwise_min(vmn, v); vmx = __builtin_elementwise_max(vmx, v); }
                    if (cb < nk) { const h16x8 v = *(const LAS h16x8*)(myS + cb + 8 * lane);
#pragma unroll
                        for (int i = 0; i < 8; ++i) if (cb + 8 * lane + i < nk) { vmn[i] = vmn[i] < v[i] ? vmn[i] : v[i]; vmx[i] = vmx[i] > v[i] ? vmx[i] : v[i]; } }
                    float a = (float)vmn[0], bmx = (float)vmx[0];
#pragma unroll
                    for (int i = 1; i < 8; ++i) { a = fminf(a, (float)vmn[i]); bmx = fmaxf(bmx, (float)vmx[i]); }
                    lo = wave_min(a); hv = wave_max(bmx);
                }
                const float scale = (hv > lo) ? 511.0f / (hv - lo) : 0.f;
                {
                    int cb = 0;
#pragma unroll 1
                    for (; cb + 512 <= nk; cb += 512) {
                        const h16x8 v = *(const LAS h16x8*)(myS + cb + 8 * lane);
#pragma unroll
                        for (int i = 0; i < 8; ++i) { const unsigned k = (unsigned)fminf(((float)v[i] - lo) * scale, 511.0f); atomicAdd((unsigned*)&myHist[k], 1u); }
                    }
                    if (cb < nk) {
                        const h16x8 v = *(const LAS h16x8*)(myS + cb + 8 * lane);
#pragma unroll
                        for (int i = 0; i < 8; ++i) if (cb + 8 * lane + i < nk) { const unsigned k = (unsigned)fminf(((float)v[i] - lo) * scale, 511.0f); atomicAdd((unsigned*)&myHist[k], 1u); }
                    }
                }
                LDS_WAIT();
                int abv1; const int T = hist_find9(myHist, 256, lane, abv1);
                const int rem2 = 256 - abv1;
                const float Tf = (float)T, Tp1 = (float)(T + 1);
                int ncand = 0;
#pragma unroll 1
                for (int cb = 0; cb < nk; cb += 512) {
                    const h16x8 v = *(const LAS h16x8*)(myS + cb + 8 * lane);
                    const bool full = cb + 512 <= nk;
#pragma unroll
                    for (int i = 0; i < 8; ++i) {
                        const int e = cb + 8 * lane + i; const float vf = (float)v[i]; const float x = (vf - lo) * scale; const bool ok = full || e < nk;
                        const bool sel = ok && x >= Tp1, cnd = ok && x >= Tf && !(x >= Tp1);
                        const unsigned long long ms = __ballot(sel), mc = __ballot(cnd);
                        if (sel) { const int pos = nsel + __popcll(ms & lt_mask); if (pos < 256) drow[pos] = (unsigned short)e; }
                        nsel += __popcll(ms);
                        if (mc) {
                            if (cnd) { const int pos = ncand + __popcll(mc & lt_mask); if (pos < CCAP) { myCv[pos] = v[i]; myCi[pos] = (unsigned short)e; } }
                            ncand += __popcll(mc);
                        }
                    }
                }
                if (ncand > CCAP) ncand = CCAP;
                LDS_WAIT();
#pragma unroll 1
                for (int c0 = 0; c0 < ncand; c0 += 64) {
                    const int ci = c0 + lane; const bool have = ci < ncand;
                    const float vi = have ? (float)myCv[ci] : 0.f; const int ii = have ? (int)myCi[ci] : 0;
                    int rank = 0;
#pragma unroll 1
                    for (int j = 0; j < ncand; ++j) { const float vj = (float)myCv[j]; const int ij = (int)myCi[j]; rank += (vj > vi || (vj == vi && ij < ii)) ? 1 : 0; }
                    const bool sel = have && rank < rem2;
                    const unsigned long long ms = __ballot(sel);
                    if (sel) { const int pos = nsel + __popcll(ms & lt_mask); if (pos < 256) drow[pos] = (unsigned short)ii; }
                    nsel += __popcll(ms);
                }
                if (nsel > 256) nsel = 256;
            }
            if (lane == 0) CNT[rowb + tq] = (unsigned short)nsel;
        }
        __syncthreads();
    }
}

typedef short s16x4 __attribute__((ext_vector_type(4)));
__device__ __forceinline__ s16x4 lds_tr16(const LAS unsigned char* p) { return __builtin_bit_cast(s16x4, __builtin_amdgcn_ds_read_tr16_b64_v4i16((LAS s16x4*)p)); }
constexpr int KROW = 144;
constexpr int VROW = 192;
__device__ __forceinline__ void dsa_attn_phase(LAS unsigned char* lds, const bf16* Pq, const unsigned short* LISTS, const unsigned short* CNT, bf16* OB, int bid, int wave, int lane_in) {
    LAS unsigned char* Vst = lds + wave * 16384;
    LAS unsigned short* Pst = (LAS unsigned short*)(lds + wave * 16384 + 6144);
    LAS unsigned short* myList = (LAS unsigned short*)(lds + wave * 16384 + 6400);
    LAS unsigned char* qst = lds + wave * 16384 + 6912;
    LAS unsigned char* Kst = lds + wave * 16384 + 7424;
    const int b = bid & 7, widx = (bid >> 3) * 8 + wave;
    const size_t rowb = (size_t)b * SEQ;
#pragma unroll 1
    for (int tq = widx; tq < SEQ; tq += 256) {
        int nsel = (int)CNT[rowb + tq]; nsel = nsel < 1 ? 1 : (nsel > 256 ? 256 : nsel); nsel = __builtin_amdgcn_readfirstlane(nsel);
#pragma unroll 1
    for (int c = 0; c < 2; ++c) {
        int lane = lane_in; asm volatile("" : "+v"(lane));
        {
            if (c == 0) {
            const u32x2 lw = *(const u32x2*)(LISTS + (rowb + tq) * 256 + 4 * lane);
            unsigned e0 = lw.x & 0xffffu, e1 = lw.x >> 16, e2 = lw.y & 0xffffu, e3 = lw.y >> 16;
            e0 = e0 > (unsigned)tq ? (unsigned)tq : e0; e1 = e1 > (unsigned)tq ? (unsigned)tq : e1; e2 = e2 > (unsigned)tq ? (unsigned)tq : e2; e3 = e3 > (unsigned)tq ? (unsigned)tq : e3;
            *(LAS u32x2*)(myList + 4 * lane) = (u32x2){e0 | (e1 << 16), e2 | (e3 << 16)};
            }
            if (lane < 32) {
                const int h = lane >> 3, chn = lane & 7;
                const u32x4 qv = lane < 24 ? *(const u32x4*)(Pq + (rowb + tq) * NQ + C_QB + (3 * c + h) * 64 + chn * 8) : (u32x4){0u, 0u, 0u, 0u};
                const int qoff = lane < 24 ? (chn * 64 + h * 16) : ((lane - 24) * 64 + 48);
                *(LAS u32x4*)(qst + qoff) = qv;
            }
        }
        LDS_WAIT();
        const int m = lane & 31, hi = lane >> 5;
        const int r8 = lane >> 3, ch8 = lane & 7;
        f32x16 O0, O1;
#pragma unroll
        for (int i = 0; i < 16; ++i) { O0[i] = 0.f; O1[i] = 0.f; }
        float lp[3] = {0.f, 0.f, 0.f};
        const int nbk = (nsel + 31) >> 5;
        const bf16* kbase = Pq + rowb * NQ + C_KB + c * 64 + ch8 * 8;
        const bf16* vbase = Pq + rowb * NQ + C_VB + c * 64 + ch8 * 8;
        const LAS unsigned char* qrd = qst + hi * 64 + (m < 3 ? m : 3) * 16;
        const LAS unsigned char* prd = (const LAS unsigned char*)Pst + (m < 3 ? m : 2) * 64 + 8 * hi;
        const LAS unsigned char* vrd = Vst + (4 * hi + ((lane & 15) >> 2)) * VROW + (((lane >> 4) & 1) * 16 + 4 * (lane & 3)) * 2;
        LAS unsigned char* vwr = Vst + r8 * VROW + ch8 * 16;
        LAS unsigned char* kwr = Kst + r8 * KROW + ch8 * 16;
        const LAS unsigned char* krd = Kst + m * KROW + hi * 16;
        u32x4 kA[4], kB[4], kC[4]; u32x4 vA[4], vB[4], vC[4];
#define KV_LOAD(kbuf, vbuf, bk_) do { _Pragma("unroll") for (int i = 0; i < 4; ++i) { const int jj_ = 32 * (bk_) + 8 * i + r8; const int key_ = (int)myList[jj_ < 256 ? jj_ : 255]; \
            kbuf[i] = *(const u32x4*)(kbase + (size_t)key_ * NQ); vbuf[i] = *(const u32x4*)(vbase + (size_t)key_ * NQ); } } while (0)
#define BLOCK(kbuf, vbuf, bk_) do { \
            _Pragma("unroll") for (int i = 0; i < 4; ++i) { *(LAS u32x4*)(vwr + 8 * i * VROW) = vbuf[i]; *(LAS u32x4*)(kwr + 8 * i * KROW) = kbuf[i]; } \
            LDS_ORDER(); \
            { f32x16 sacc; \
                _Pragma("unroll") for (int i = 0; i < 16; ++i) sacc[i] = 0.f; \
                _Pragma("unroll") for (int ks = 0; ks < 4; ++ks) { const bf16x8 qa = *(const LAS bf16x8*)(qrd + ks * 128); const bf16x8 kf = *(const LAS bf16x8*)(krd + ks * 32); sacc = MFMA32(qa, kf, sacc); } \
                const bool pv_ = (lane < 32) && (32 * (bk_) + m < nsel); \
                _Pragma("unroll") for (int g = 0; g < 3; ++g) { const float p = pv_ ? __expf(sacc[g] * 0.125f) : 0.f; lp[g] += p; if (lane < 32) Pst[g * 32 + m] = (unsigned short)f2bf(p); } } \
            LDS_ORDER(); \
            _Pragma("unroll") for (int s2 = 0; s2 < 2; ++s2) { \
                const u32x2 pl = *(const LAS u32x2*)(prd + s2 * 32), ph = *(const LAS u32x2*)(prd + s2 * 32 + 16); \
                const bf16x8 pb = __builtin_bit_cast(bf16x8, (u32x4){pl.x, pl.y, ph.x, ph.y}); \
                _Pragma("unroll") for (int db = 0; db < 2; ++db) { \
                    const s16x4 vl = lds_tr16(vrd + s2 * 16 * VROW + db * 64), vh = lds_tr16(vrd + (s2 * 16 + 8) * VROW + db * 64); \
                    const bf16x8 va = (bf16x8){vl[0], vl[1], vl[2], vl[3], vh[0], vh[1], vh[2], vh[3]}; \
                    if (db == 0) O0 = MFMA32(va, pb, O0); else O1 = MFMA32(va, pb, O1); } } \
            LDS_ORDER(); } while (0)
        KV_LOAD(kA, vA, 0);
        KV_LOAD(kB, vB, 1);
#pragma unroll 1
        for (int bk = 0; bk < nbk; bk += 3) {
            KV_LOAD(kC, vC, bk + 2);
            BLOCK(kA, vA, bk);
            KV_LOAD(kA, vA, bk + 3);
            if (bk + 1 < nbk) BLOCK(kB, vB, bk + 1);
            KV_LOAD(kB, vB, bk + 4);
            if (bk + 2 < nbk) BLOCK(kC, vC, bk + 2);
        }
#undef KV_LOAD
#undef BLOCK
#pragma unroll
        for (int h = 0; h < 3; ++h) lp[h] = wave_sum(lp[h]);
        if (m < 3) {
            const float l0 = m == 0 ? lp[0] : (m == 1 ? lp[1] : lp[2]);
            const float i0 = 1.0f / l0;
            bf16* o0 = OB + (rowb + tq) * 384 + (3 * c + m) * 64 + 4 * hi;
#pragma unroll
            for (int g4 = 0; g4 < 4; ++g4) {
                u32x2 w;
                w.x = pk2(O0[4 * g4] * i0, O0[4 * g4 + 1] * i0); w.y = pk2(O0[4 * g4 + 2] * i0, O0[4 * g4 + 3] * i0); *(u32x2*)(o0 + 8 * g4) = w;
                w.x = pk2(O1[4 * g4] * i0, O1[4 * g4 + 1] * i0); w.y = pk2(O1[4 * g4 + 2] * i0, O1[4 * g4 + 3] * i0); *(u32x2*)(o0 + 32 + 8 * g4) = w;
            }
        }
        LDS_WAIT();
    }
    }
}

#define XB_TMO      128
#define XB_XCNT(j)  (256  + 64 * (j))
#define XB_XSUB(j)  (1280 + 64 * (j))
#define XB_XGEN(j)  (2304 + 64 * (j))
#define XB_TOP      3328
#define XB_TOPGEN   3392
#define XCD_BAR_WORDS 3456
#define XB_SPIN_CAP (1u << 18)

__device__ __forceinline__ unsigned xb_ld(unsigned* p)              { return __hip_atomic_load(p, __ATOMIC_RELAXED, __HIP_MEMORY_SCOPE_AGENT); }
__device__ __forceinline__ unsigned xb_add(unsigned* p, unsigned v) { return __hip_atomic_fetch_add(p, v, __ATOMIC_RELAXED, __HIP_MEMORY_SCOPE_AGENT); }
__device__ __forceinline__ unsigned xb_xcc_id() { return (unsigned)__builtin_amdgcn_s_getreg((3 << 11) | 20) & 0xFu; }
#define XB_SPIN(cond, bar) do { unsigned _sp = 0; while (cond) { __builtin_amdgcn_s_sleep(1); \
    if ((++_sp & 255u) == 0u) { if (xb_ld(&(bar)[XB_TMO])) break; if (_sp > XB_SPIN_CAP) { atomicAdd(&(bar)[XB_TMO], 1u); break; } } } } while (0)

struct XcdBarrier {
    unsigned* bar; unsigned x;
    volatile LAS unsigned* st;
};

__device__ __forceinline__ XcdBarrier xcd_barrier_post(unsigned* bar, volatile LAS unsigned* st) {
    XcdBarrier b; b.bar = bar; b.x = xb_xcc_id(); b.st = st;
    if (threadIdx.x == 0) (void)xb_add(&bar[XB_XCNT(b.x)], 1u);
    return b;
}
__device__ __forceinline__ void xcd_barrier_complete(unsigned* bar, unsigned x, unsigned& nloc, unsigned& nx) {
    const unsigned G = gridDim.x * gridDim.y * gridDim.z;
    unsigned sum, cnt, mine, sp = 0u;
    for (;;) {
        sum = 0u; cnt = 0u; mine = 0u;
#pragma unroll
        for (unsigned j = 0; j < 16; ++j) { const unsigned c = xb_ld(&bar[XB_XCNT(j)]); sum += c; cnt += (c > 0u) ? 1u : 0u; mine = (j == x) ? c : mine; }
        if (sum == G) break;
        __builtin_amdgcn_s_sleep(1);
        if ((++sp & 255u) == 0u) { if (xb_ld(&bar[XB_TMO])) break; if (sp > XB_SPIN_CAP) { atomicAdd(&bar[XB_TMO], 1u); break; } }
    }
    nloc = mine > 0u ? mine : 1u; nx = cnt > 0u ? cnt : 1u;
}

__device__ __forceinline__ void xcd_barrier(const XcdBarrier& b) {
    asm volatile("s_waitcnt vmcnt(0)" ::: "memory");
    __syncthreads();
    if (threadIdx.x == 0) {
        unsigned* bar = b.bar;
        __builtin_amdgcn_s_waitcnt(0);
        unsigned nloc = b.st[0], nx = b.st[1];
        if (nloc == 0u) { xcd_barrier_complete(bar, b.x, nloc, nx); b.st[0] = nloc; b.st[1] = nx; }
        const unsigned old = xb_add(&bar[XB_XSUB(b.x)], 1u);
        const unsigned gen = old / nloc;
        if (old + 1u == (gen + 1u) * nloc) {
            __builtin_amdgcn_fence(__ATOMIC_RELEASE, "agent");
            asm volatile("s_waitcnt vmcnt(0)" ::: "memory");
            const unsigned og = xb_add(&bar[XB_TOP], 1u);
            const unsigned tg = og / nx;
            if (og + 1u == (tg + 1u) * nx) xb_add(&bar[XB_TOPGEN], 1u);
            else XB_SPIN(xb_ld(&bar[XB_TOPGEN]) == tg, bar);
            __builtin_amdgcn_fence(__ATOMIC_ACQUIRE, "agent");
            xb_add(&bar[XB_XGEN(b.x)], 1u);
            asm volatile("s_waitcnt vmcnt(0)" ::: "memory");
        } else {
            XB_SPIN(xb_ld(&bar[XB_XGEN(b.x)]) == gen, bar);
            __builtin_amdgcn_fence(__ATOMIC_ACQUIRE, "agent");
            asm volatile("s_waitcnt vmcnt(0)" ::: "memory");
        }
    }
    __syncthreads();
}

__global__ void __launch_bounds__(NWAVES * 64, 2) hybrid_fwd(Args args) {
    extern __shared__ __attribute__((aligned(16))) unsigned char lds_raw[];
    LAS unsigned char* lds = (LAS unsigned char*)lds_raw;
    const int G = gridDim.x, bid = blockIdx.x, NGW = G * NWAVES;
#define IDS int tid_ = threadIdx.x; asm volatile("" : "+v"(tid_)); const int lane = tid_ & 63, wave = __builtin_amdgcn_readfirstlane(tid_ >> 6), gw = bid * NWAVES + wave; (void)lane; (void)gw
    const int lo = args.ph_lo, hi = args.ph_hi;
    cg::grid_group grid = cg::this_grid();
    volatile LAS unsigned* bst = (volatile LAS unsigned*)(lds + LDS_BYTES - 16);
    if (threadIdx.x < 2) bst[threadIdx.x] = 0u;
    __syncthreads();
    XcdBarrier xbar = xcd_barrier_post((unsigned*)(args.ws + WS_CTL), bst);
#define IN(k) (lo <= (k) && (k) < hi)
#define KA KArgs ap = (KArgs)__builtin_amdgcn_kernarg_segment_ptr(); asm volatile("" : "+s"(ap)); unsigned char* ws = ap->ws; bf16* Pq = (bf16*)(ws + WS_PQ); bf16* Gt = (bf16*)(ws + WS_G); (void)Pq; (void)Gt
#define SEAM(k) do { if (IN(k) && IN((k) + 1)) xcd_barrier(xbar); } while (0)
    if (hi < 0) grid.sync();
    if (IN(0)) { IDS; KA; p0_prologue(ap, lds, gw, NGW, wave, lane); }
    SEAM(0);
    if (IN(1)) {
        KA;
        { pg8::Gemm g{(const bf16*)(ws + WS_H), (const bf16*)(ws + WS_WIN), MTOK, NPROJ, DM}; pg8::StaticOrder S; S.init(MTOK, NPROJ, G, bid);
          pg8::EpiProj E{Pq, Gt}; pg8::gemm_phase<pg8::EpiProj, pg8::StaticOrder, true, true>(lds, g, S, E); }
        __syncthreads();
        { pg8::Gemm g{(const bf16*)(ws + WS_HM), (const bf16*)(ws + WS_WMEM), MROWS, 512, DM}; pg8::StaticOrder S; S.init(MROWS, 512, G, bid);
          pg8::EpiBf16<0> E{(bf16*)(ws + WS_MKV), 512}; pg8::gemm_phase<pg8::EpiBf16<0>, pg8::StaticOrder, true, true>(lds, g, S, E); }
    }
    SEAM(1);
    if (IN(2)) { IDS; KA; p2_normrot(ap, gw, NGW, lane); }
    SEAM(2);
    if (IN(3)) {
        IDS; KA;
        for (int uid = gw; uid < 4096; uid += NGW) dilated_unit(lds + wave * 16384, Pq, (bf16*)(ws + WS_OA), uid >> 9, (uid >> 8) & 1, (uid >> 4) & 15, uid & 15, lane);
        for (int uid = gw; uid < 8192; uid += NGW) mem_unit(lds + wave * 16384, Pq, (const bf16*)(ws + WS_MKV), (bf16*)(ws + WS_OC), uid >> 10, (uid >> 8) & 3, uid & 255, lane);
        __syncthreads();
        dsa_select_phase(lds, Pq, (const bf16*)(ws + WS_KIF), (unsigned short*)(ws + WS_LISTS), (unsigned short*)(ws + WS_CNT), G, bid, wave, lane);
        xcd_barrier(xbar);
        dsa_attn_phase(lds, Pq, (const unsigned short*)(ws + WS_LISTS), (const unsigned short*)(ws + WS_CNT), (bf16*)(ws + WS_OB), bid, wave, lane);
    }
    SEAM(3);
    if (IN(4)) {
        KA; bf16* mrg = (bf16*)(ws + WS_MERGED);
        pg8::StaticOrder S; S.init(MTOK, DM, G, bid);
        { pg8::Gemm g{(const bf16*)(ws + WS_OA), (const bf16*)(ws + WS_WA), MTOK, DM, 128}; pg8::EpiGate<0> E{Gt, 0, mrg};
          pg8::gemm_phase<pg8::EpiGate<0>, pg8::StaticOrder, true, true>(lds, g, S, E); }
        __syncthreads();
        { pg8::Gemm g{(const bf16*)(ws + WS_OB), (const bf16*)(ws + WS_WB), MTOK, DM, 384}; pg8::EpiGate<1> E{Gt, 1024, mrg};
          pg8::gemm_phase<pg8::EpiGate<1>, pg8::StaticOrder, true, true>(lds, g, S, E); }
        __syncthreads();
        { pg8::Gemm g{(const bf16*)(ws + WS_OC), (const bf16*)(ws + WS_WC), MTOK, DM, 256}; pg8::EpiGate<1> E{Gt, 2048, mrg};
          pg8::gemm_phase<pg8::EpiGate<1>, pg8::StaticOrder, true, true>(lds, g, S, E); }
    }
    SEAM(4);
    if (IN(5)) {
        KA;
        pg8::Gemm g{(const bf16*)(ws + WS_MERGED), (const bf16*)(ws + WS_WO), MTOK, DM, DM}; pg8::StaticOrder S; S.init(MTOK, DM, G, bid);
        pg8::EpiRes E{ap->in[0], ap->out}; pg8::gemm_phase<pg8::EpiRes, pg8::StaticOrder, true, true>(lds, g, S, E);
    }
    SEAM(5);
    if (IN(6)) { IDS; KA; const float* xo_ = ap->out; const float* gm_ = ap->in[17]; for (int m = gw; m < MTOK; m += NGW) rms_row_to_bf16(xo_ + (size_t)m * DM, gm_, (bf16*)(ws + WS_H) + (size_t)m * DM, lane); }
    SEAM(6);
    if (IN(7)) {
        KA;
        pg8::Gemm g{(const bf16*)(ws + WS_H), (const bf16*)(ws + WS_W1), MTOK, FF, DM}; pg8::StaticOrder S; S.init(MTOK, FF, G, bid);
        pg8::EpiBf16<1> E{(bf16*)(ws + WS_HID), FF}; pg8::gemm_phase<pg8::EpiBf16<1>, pg8::StaticOrder, true, true>(lds, g, S, E);
    }
    SEAM(7);
    if (IN(8)) {
        KA; float* outp = ap->out;
        pg8::Gemm g{(const bf16*)(ws + WS_HID), (const bf16*)(ws + WS_W2), MTOK, DM, FF}; pg8::StaticOrder S; S.init(MTOK, DM, G, bid);
        pg8::EpiRes E{outp, outp}; pg8::gemm_phase<pg8::EpiRes, pg8::StaticOrder, true, true>(lds, g, S, E);
    }
#undef IN
#undef KA
#undef SEAM
}

#ifndef MK_ONE_LAUNCH
#define MK_ONE_LAUNCH 1
#endif
constexpr int N_PHASES = 9;
extern "C" void kernel_launch(void* const* d_in, const int* in_sizes, int n_in, void* d_out, int out_size, void* d_ws, size_t ws_size, hipStream_t stream) {
    static int grid = 0;
    if (grid == 0) {
        if (n_in != 20 || out_size != MTOK * DM || ws_size < WS_END) { fprintf(stderr, "kernel_launch: unexpected shapes: n_in %d out %d ws %zu (need %zu)\n", n_in, out_size, ws_size, (size_t)WS_END); grid = -1; return; }
        int dev = 0, cus = 0, per_cu = 0;
        hipGetDevice(&dev); hipDeviceGetAttribute(&cus, hipDeviceAttributeMultiprocessorCount, dev);
        if (hipFuncSetAttribute((const void*)hybrid_fwd, hipFuncAttributeMaxDynamicSharedMemorySize, LDS_BYTES) != hipSuccess) { fprintf(stderr, "kernel_launch: hipFuncSetAttribute failed\n"); grid = -1; return; }
        if (hipOccupancyMaxActiveBlocksPerMultiprocessor(&per_cu, (const void*)hybrid_fwd, NWAVES * 64, LDS_BYTES) != hipSuccess || per_cu < 1) { fprintf(stderr, "kernel_launch: occupancy query says %d\n", per_cu); per_cu = 1; }
        (void)hipGetLastError();
        grid = cus > 0 ? cus : 256;
    }
    if (grid < 0) return;
    if (hipMemsetAsync((char*)d_ws + WS_CTL, 0, CTL_BYTES, stream) != hipSuccess) { fprintf(stderr, "kernel_launch: hipMemsetAsync failed\n"); return; }
    Args a{};
    for (int i = 0; i < 20; ++i) a.in[i] = (const float*)d_in[i];
    a.out = (float*)d_out; a.ws = (unsigned char*)d_ws;
#if MK_ONE_LAUNCH
    a.ph_lo = 0; a.ph_hi = N_PHASES;
    void* kargs[] = {&a};
    hipError_t e = hipLaunchCooperativeKernel((const void*)hybrid_fwd, dim3(grid), dim3(NWAVES * 64), kargs, LDS_BYTES, stream);
    if (e != hipSuccess) fprintf(stderr, "kernel_launch: cooperative launch failed: %s (grid %d)\n", hipGetErrorString(e), grid);
#else
    for (int p = 0; p < N_PHASES; ++p) {
        a.ph_lo = p; a.ph_hi = p + 1;
        hipLaunchKernelGGL(hybrid_fwd, dim3(grid), dim3(NWAVES * 64), LDS_BYTES, stream, a);
    }
#endif
}
```

```cpp
#include <hip/hip_runtime.h>
#include <hip/hip_cooperative_groups.h>
#include <cstdio>
#include <cstdint>
namespace cg = cooperative_groups;
namespace pg8 {
#define PG8_LAS __attribute__((address_space(3)))
typedef unsigned short bf16_t;
typedef short bf16x8 __attribute__((ext_vector_type(8)));
typedef float f32x4 __attribute__((ext_vector_type(4)));
typedef unsigned u32x4 __attribute__((ext_vector_type(4)));
constexpr int BM = 256, BK = 64, HALF = 128, HTB = HALF * BK * 2  , STAGE_BYTES = 8 * HTB, NXCD = 8, WGM = 8;

__host__ __device__ __forceinline__ int lds_byte(int r, int c) { const int st = (r >> 4) * 2 + (c >> 5), rr = r & 15, cc = c & 31, ob = rr * 64 + cc * 2; return st * 1024 + (ob ^ (((ob >> 9) & 1) << 5)); }
__host__ __device__ __forceinline__ void stage_rc(int b, int& R, int& C) { const int st = b / 1024, sb = b % 1024, swz = sb ^ (((sb >> 9) & 1) << 5); R = (st >> 1) * 16 + swz / 64; C = (st & 1) * 32 + (swz % 64) / 2; }
__host__ __device__ __forceinline__ int perm32(int rho) { const int n = rho >> 4, i = rho & 15; return 8 * (i >> 2) + 4 * n + (i & 3); }

struct Unit { int pm, pn; };
struct Gemm { const bf16_t* A; const bf16_t* Bt; int M, N, K; };

struct StaticOrder {
    int nM, nN, nwg, G, c;
    __host__ __device__ void init(int M, int N, int G_, int c_) { nM = M / BM; nN = N / BM; nwg = nM * nN; G = G_; c = c_; }
    __host__ __device__ bool next(int i, Unit& u) const {
        const long L = (long)i * G + c; if (L >= nwg) return false;
        int wgid = (int)L; { const int q = nwg / NXCD, r = nwg % NXCD, xcd = wgid % NXCD, off = wgid / NXCD; wgid = (xcd < r ? xcd * (q + 1) : r * (q + 1) + (xcd - r) * q) + off; }
        const int nig = WGM * nN, gid = wgid / nig, fm = gid * WGM, gsz = (nM - fm) < WGM ? (nM - fm) : WGM;
        u.pm = fm + ((wgid % nig) % gsz); u.pn = (wgid % nig) / gsz; return true;
    }
    __device__ __forceinline__ void a_ready(const Unit&) const {}
    __device__ __forceinline__ void done(const Unit&) const {}
};

__device__ __forceinline__ unsigned cvt_pk_bf16(float lo, float hi) { unsigned r; asm volatile("v_cvt_pk_bf16_f32 %0, %1, %2" : "=v"(r) : "v"(lo), "v"(hi)); return r; }
typedef unsigned u32x2 __attribute__((ext_vector_type(2)));
__device__ __forceinline__ float bf_lo(unsigned w) { return __uint_as_float(w << 16); }
__device__ __forceinline__ float bf_hi(unsigned w) { return __uint_as_float(w & 0xffff0000u); }
__device__ __forceinline__ float sigmoidf_(float x) { return __builtin_amdgcn_rcpf(1.0f + __expf(-x)); }
struct EpiProj {
    static constexpr bool PERM = true, AFTER_DRAIN = false;
    bf16_t* Pq; bf16_t* G;
    __device__ __forceinline__ void operator()(const f32x4 (&acc)[2][2][4][2], const Unit& u, int wr, int wc, int fr, int fq) const {
        const bool gate = u.pn >= 11;
        bf16_t* base = gate ? G : Pq; const int ldc = gate ? 3072 : 2816;
        const int colt = (gate ? u.pn - 11 : u.pn) * BM;
        const int row0 = u.pm * BM + wr * 64 + fr, col0 = colt + wc * 32 + 8 * fq;
#pragma unroll
        for (int ai = 0; ai < 2; ++ai)
#pragma unroll
            for (int m = 0; m < 4; ++m) { bf16_t* rowp = base + (size_t)(row0 + ai * HALF + m * 16) * ldc + col0;
#pragma unroll
                for (int bj = 0; bj < 2; ++bj) { f32x4 v0 = acc[ai][bj][m][0], v1 = acc[ai][bj][m][1];
                    if (gate) { v0 = (f32x4){sigmoidf_(v0[0]), sigmoidf_(v0[1]), sigmoidf_(v0[2]), sigmoidf_(v0[3])}; v1 = (f32x4){sigmoidf_(v1[0]), sigmoidf_(v1[1]), sigmoidf_(v1[2]), sigmoidf_(v1[3])}; }
                    u32x4 w; w.x = cvt_pk_bf16(v0[0], v0[1]); w.y = cvt_pk_bf16(v0[2], v0[3]); w.z = cvt_pk_bf16(v1[0], v1[1]); w.w = cvt_pk_bf16(v1[2], v1[3]);
                    *(u32x4*)(rowp + bj * HALF) = w; } }
    }
};
template <int ACT> struct EpiBf16 {
    static constexpr bool PERM = true, AFTER_DRAIN = false;
    bf16_t* O; int ldc;
    __device__ __forceinline__ void operator()(const f32x4 (&acc)[2][2][4][2], const Unit& u, int wr, int wc, int fr, int fq) const {
        const int row0 = u.pm * BM + wr * 64 + fr, col0 = u.pn * BM + wc * 32 + 8 * fq;
#pragma unroll
        for (int ai = 0; ai < 2; ++ai)
#pragma unroll
            for (int m = 0; m < 4; ++m) { bf16_t* rowp = O + (size_t)(row0 + ai * HALF + m * 16) * ldc + col0;
#pragma unroll
                for (int bj = 0; bj < 2; ++bj) { f32x4 v0 = acc[ai][bj][m][0], v1 = acc[ai][bj][m][1];
                    if (ACT == 1) {
#pragma unroll
                        for (int e = 0; e < 4; ++e) { const float a = fmaxf(v0[e], 0.f), b = fmaxf(v1[e], 0.f); v0[e] = a * a; v1[e] = b * b; } }
                    u32x4 w; w.x = cvt_pk_bf16(v0[0], v0[1]); w.y = cvt_pk_bf16(v0[2], v0[3]); w.z = cvt_pk_bf16(v1[0], v1[1]); w.w = cvt_pk_bf16(v1[2], v1[3]);
                    *(u32x4*)(rowp + bj * HALF) = w; } }
    }
};
template <int MODE> struct EpiGate {
    static constexpr bool PERM = true, AFTER_DRAIN = false;
    const bf16_t* G; int gofs; bf16_t* merged;
    __device__ __forceinline__ void operator()(const f32x4 (&acc)[2][2][4][2], const Unit& u, int wr, int wc, int fr, int fq) const {
        const int row0 = u.pm * BM + wr * 64 + fr, col0 = u.pn * BM + wc * 32 + 8 * fq;
#pragma unroll
        for (int ai = 0; ai < 2; ++ai)
#pragma unroll
            for (int m = 0; m < 4; ++m) { const size_t r = (size_t)(row0 + ai * HALF + m * 16);
#pragma unroll
                for (int bj = 0; bj < 2; ++bj) { const int c = col0 + bj * HALF;
                    const u32x4 gw = *(const u32x4*)(G + r * 3072 + gofs + c);
                    f32x4 v0 = acc[ai][bj][m][0], v1 = acc[ai][bj][m][1];
                    v0[0] *= bf_lo(gw.x); v0[1] *= bf_hi(gw.x); v0[2] *= bf_lo(gw.y); v0[3] *= bf_hi(gw.y); v1[0] *= bf_lo(gw.z); v1[1] *= bf_hi(gw.z); v1[2] *= bf_lo(gw.w); v1[3] *= bf_hi(gw.w);
                    u32x4* mp = (u32x4*)(merged + r * 1024 + c);
                    if (MODE >= 1) { const u32x4 pw = *mp; v0[0] += bf_lo(pw.x); v0[1] += bf_hi(pw.x); v0[2] += bf_lo(pw.y); v0[3] += bf_hi(pw.y); v1[0] += bf_lo(pw.z); v1[1] += bf_hi(pw.z); v1[2] += bf_lo(pw.w); v1[3] += bf_hi(pw.w); }
                    u32x4 w; w.x = cvt_pk_bf16(v0[0], v0[1]); w.y = cvt_pk_bf16(v0[2], v0[3]); w.z = cvt_pk_bf16(v1[0], v1[1]); w.w = cvt_pk_bf16(v1[2], v1[3]);
                    *mp = w; } }
    }
};
struct EpiRes {
    static constexpr bool PERM = true, AFTER_DRAIN = false;
    const float* base; float* out;
    __device__ __forceinline__ void operator()(const f32x4 (&acc)[2][2][4][2], const Unit& u, int wr, int wc, int fr, int fq) const {
        const int row0 = u.pm * BM + wr * 64 + fr, col0 = u.pn * BM + wc * 32 + 8 * fq;
#pragma unroll
        for (int ai = 0; ai < 2; ++ai)
#pragma unroll
            for (int m = 0; m < 4; ++m) { const size_t r = (size_t)(row0 + ai * HALF + m * 16);
#pragma unroll
                for (int bj = 0; bj < 2; ++bj) { const int c = col0 + bj * HALF;
                    const f32x4 b0 = *(const f32x4*)(base + r * 1024 + c), b1 = *(const f32x4*)(base + r * 1024 + c + 4);
                    *(f32x4*)(out + r * 1024 + c) = b0 + acc[ai][bj][m][0]; *(f32x4*)(out + r * 1024 + c + 4) = b1 + acc[ai][bj][m][1]; } }
    }
};
template <class Epi, class Sched, bool ALIGN_EPI = false, bool SP2 = false>
__device__ __forceinline__ void gemm_phase(PG8_LAS unsigned char* lds, const Gemm g, const Sched& S, const Epi& E) {
    int tid_l = threadIdx.x; asm volatile("" : "+v"(tid_l));
    const int tid = tid_l, wid = __builtin_amdgcn_readfirstlane(tid >> 6), lane = tid & 63, wr = wid >> 2, wc = wid & 3, fr = lane & 15, fq = lane >> 4;
    const int K = g.K, nt = K / BK;
    unsigned voffA[2], voffB[2];
#pragma unroll
    for (int i = 0; i < 2; ++i) { int R, C; stage_rc(tid * 16 + i * 8192, R, C); const int Rb = Epi::PERM ? ((R & ~31) + perm32(R & 31)) : R;
        voffA[i] = (unsigned)(R * K + C) * 2u; voffB[i] = (unsigned)(Rb * K + C) * 2u; }
    const size_t kstep = (size_t)(BK * 2);
    const size_t hstep = (size_t)HALF * K * 2;
    const size_t tstep = 2 * hstep;
    const unsigned ldsw = (unsigned)wid * 1024u;
    const int aoff = lds_byte(wr * 64 + fr, fq * 8), boff = lds_byte(wc * 32 + fr, fq * 8);
#define PG8_SA(b, h) (((b) * 2 + (h)) * HTB)
#define PG8_SB(b, h) ((4 + (b) * 2 + (h)) * HTB)
#define PG8_STAGE(bufoff, gbase, voff) do { _Pragma("unroll") for (int _i = 0; _i < 2; ++_i) \
        __builtin_amdgcn_global_load_lds((const unsigned*)((const char*)(gbase) + (voff)[_i]), (PG8_LAS unsigned*)(lds + (bufoff) + ldsw + _i * 8192), 16, 0, 0); } while (0)
#define PG8_LDA(dst, b, h) do { _Pragma("unroll") for (int m = 0; m < 4; ++m) _Pragma("unroll") for (int k = 0; k < 2; ++k) dst[m][k] = *(const PG8_LAS bf16x8*)(lds + PG8_SA(b, h) + aoff + m * 2048 + k * 1024); } while (0)
#define PG8_LDB(dst, b, h) do { _Pragma("unroll") for (int n = 0; n < 2; ++n) _Pragma("unroll") for (int k = 0; k < 2; ++k) dst[n][k] = *(const PG8_LAS bf16x8*)(lds + PG8_SB(b, h) + boff + n * 2048 + k * 1024); } while (0)
#define PG8_MMA(ai, bj, At, Bt) do { __builtin_amdgcn_s_setprio(1); _Pragma("unroll") for (int m = 0; m < 4; ++m) _Pragma("unroll") for (int n = 0; n < 2; ++n) _Pragma("unroll") for (int k = 0; k < 2; ++k) \
        acc[ai][bj][m][n] = __builtin_amdgcn_mfma_f32_16x16x32_bf16(Bt[n][k], At[m][k], acc[ai][bj][m][n], 0, 0, 0); __builtin_amdgcn_s_setprio(0); } while (0)
#define PG8_WAIT_V(n) asm volatile("s_waitcnt vmcnt(" #n ")" ::: "memory")
#define PG8_WAIT_L(n) asm volatile("s_waitcnt lgkmcnt(" #n ")" ::: "memory")
#define PG8_BAR __builtin_amdgcn_s_barrier()
#define PG8_SCHED __builtin_amdgcn_sched_barrier(0)
    Unit cur, nxt; int ui = 0;
    if (!S.next(0, cur)) return;
    f32x4 acc[2][2][4][2];
#pragma unroll
    for (int a = 0; a < 2; ++a)
#pragma unroll
        for (int b = 0; b < 2; ++b)
#pragma unroll
            for (int m = 0; m < 4; ++m)
#pragma unroll
                for (int n = 0; n < 2; ++n) acc[a][b][m][n] = (f32x4){0.f, 0.f, 0.f, 0.f};
    bf16x8 At[4][2], B0[2][2], B1[2][2];
    const char* cA = (const char*)g.A + (size_t)cur.pm * tstep; const char* cB = (const char*)g.Bt + (size_t)cur.pn * tstep;
    S.a_ready(cur);
    if constexpr (SP2) {
        PG8_STAGE(PG8_SB(0, 0), cB, voffB); PG8_STAGE(PG8_SB(0, 1), cB + hstep, voffB); PG8_STAGE(PG8_SA(0, 0), cA, voffA); PG8_STAGE(PG8_SA(0, 1), cA + hstep, voffA);
        if (wr == 1) PG8_BAR;
        PG8_WAIT_V(2); PG8_BAR;
        PG8_STAGE(PG8_SB(1, 0), cB + kstep, voffB); PG8_STAGE(PG8_SA(1, 0), cA + kstep, voffA); PG8_STAGE(PG8_SB(1, 1), cB + hstep + kstep, voffB);
        PG8_WAIT_V(6); PG8_BAR;
    } else {
        PG8_STAGE(PG8_SB(0, 0), cB, voffB); PG8_STAGE(PG8_SA(0, 0), cA, voffA); PG8_STAGE(PG8_SB(0, 1), cB + hstep, voffB); PG8_STAGE(PG8_SA(0, 1), cA + hstep, voffA);
        if (wr == 1) PG8_BAR;
        PG8_WAIT_V(4); PG8_BAR;
        PG8_STAGE(PG8_SB(1, 0), cB + kstep, voffB); PG8_STAGE(PG8_SA(1, 0), cA + kstep, voffA); PG8_STAGE(PG8_SB(1, 1), cB + hstep + kstep, voffB);
        PG8_WAIT_V(6); PG8_BAR;
    }
    for (;;) {
        const bool has_next = S.next(ui + 1, nxt);
        const char* nA = has_next ? (const char*)g.A + (size_t)nxt.pm * tstep : cA; const char* nB = has_next ? (const char*)g.Bt + (size_t)nxt.pn * tstep : cB;
        for (int t = 0; t < nt; t += 2) {
            const bool last = (t == nt - 2);
            const char* a1 = cA + (size_t)(t + 1) * kstep;
            const char* a2 = last ? nA : cA + (size_t)(t + 2) * kstep; const char* b2 = last ? nB : cB + (size_t)(t + 2) * kstep;
            const char* a3 = a2 + kstep; const char* b3 = b2 + kstep;
            if (last && has_next) S.a_ready(nxt);
            if constexpr (SP2) {
            PG8_LDB(B0, 0, 0); PG8_LDB(B1, 0, 1); PG8_SCHED; PG8_LDA(At, 0, 0); PG8_STAGE(PG8_SA(1, 1), a1 + hstep, voffA);
            PG8_WAIT_V(8); PG8_WAIT_L(0); PG8_BAR; PG8_MMA(0, 0, At, B0); PG8_MMA(0, 1, At, B1); PG8_BAR; PG8_SCHED;
            PG8_LDA(At, 0, 1); PG8_STAGE(PG8_SB(0, 0), b2, voffB); PG8_STAGE(PG8_SB(0, 1), b2 + hstep, voffB); PG8_STAGE(PG8_SA(0, 0), a2, voffA);
            PG8_WAIT_V(8); PG8_WAIT_L(0); PG8_BAR; PG8_MMA(1, 0, At, B0); PG8_MMA(1, 1, At, B1); PG8_BAR; PG8_SCHED;
            PG8_LDB(B0, 1, 0); PG8_LDB(B1, 1, 1); PG8_SCHED; PG8_LDA(At, 1, 0); PG8_STAGE(PG8_SA(0, 1), a2 + hstep, voffA);
            PG8_WAIT_V(8); PG8_WAIT_L(0); PG8_BAR; PG8_MMA(0, 0, At, B0); PG8_MMA(0, 1, At, B1); PG8_BAR; PG8_SCHED;
            PG8_LDA(At, 1, 1); PG8_STAGE(PG8_SB(1, 0), b3, voffB); PG8_STAGE(PG8_SB(1, 1), b3 + hstep, voffB); PG8_STAGE(PG8_SA(1, 0), a3, voffA);
            PG8_WAIT_V(8); PG8_WAIT_L(0); PG8_BAR; PG8_MMA(1, 0, At, B0); PG8_MMA(1, 1, At, B1); PG8_BAR; PG8_SCHED;
            } else {
            PG8_LDB(B0, 0, 0); PG8_SCHED; PG8_LDA(At, 0, 0); PG8_STAGE(PG8_SA(1, 1), a1 + hstep, voffA);
            PG8_WAIT_L(8); PG8_BAR; PG8_WAIT_L(0); PG8_MMA(0, 0, At, B0); PG8_BAR; PG8_SCHED;
            PG8_LDB(B1, 0, 1); PG8_STAGE(PG8_SB(0, 0), b2, voffB);
            PG8_BAR; PG8_WAIT_L(0); PG8_MMA(0, 1, At, B1); PG8_BAR;
            PG8_LDA(At, 0, 1); PG8_STAGE(PG8_SA(0, 0), a2, voffA);
            PG8_BAR; PG8_WAIT_L(0); PG8_MMA(1, 0, At, B0); PG8_BAR; PG8_SCHED;
            PG8_STAGE(PG8_SB(0, 1), b2 + hstep, voffB);
            PG8_WAIT_V(6); PG8_BAR; PG8_MMA(1, 1, At, B1); PG8_BAR;
            PG8_LDB(B0, 1, 0); PG8_SCHED; PG8_LDA(At, 1, 0); PG8_STAGE(PG8_SA(0, 1), a2 + hstep, voffA);
            PG8_WAIT_L(8); PG8_BAR; PG8_WAIT_L(0); PG8_MMA(0, 0, At, B0); PG8_BAR; PG8_SCHED;
            PG8_LDB(B1, 1, 1); PG8_STAGE(PG8_SB(1, 0), b3, voffB);
            PG8_BAR; PG8_WAIT_L(0); PG8_MMA(0, 1, At, B1); PG8_BAR;
            PG8_LDA(At, 1, 1); PG8_STAGE(PG8_SA(1, 0), a3, voffA);
            PG8_BAR; PG8_WAIT_L(0); PG8_MMA(1, 0, At, B0); PG8_BAR; PG8_SCHED;
            PG8_STAGE(PG8_SB(1, 1), b3 + hstep, voffB);
            PG8_WAIT_V(6); PG8_BAR; PG8_MMA(1, 1, At, B1); PG8_BAR;
            }
        }
        if constexpr (ALIGN_EPI) { if (wr == 0) PG8_BAR; }
        if constexpr (!Epi::AFTER_DRAIN) { E(acc, cur, wr, wc, fr, fq); S.done(cur); }
        if (!has_next) break;
#pragma unroll
        for (int a = 0; a < 2; ++a)
#pragma unroll
            for (int b = 0; b < 2; ++b)
#pragma unroll
                for (int m = 0; m < 4; ++m)
#pragma unroll
                    for (int n = 0; n < 2; ++n) acc[a][b][m][n] = (f32x4){0.f, 0.f, 0.f, 0.f};
        cur = nxt; cA = nA; cB = nB; ++ui;
        if constexpr (ALIGN_EPI) { if (wr == 1) PG8_BAR; }
    }
    PG8_WAIT_V(0);
    if constexpr (!ALIGN_EPI) { if (wr == 0) PG8_BAR; }
    PG8_BAR;
    if constexpr (Epi::AFTER_DRAIN) { E.fused(acc, cur, wr, wc, fr, fq, lds, wid, lane); S.done(cur); }
#undef PG8_SA
#undef PG8_SB
#undef PG8_STAGE
#undef PG8_LDA
#undef PG8_LDB
#undef PG8_MMA
#undef PG8_WAIT_V
#undef PG8_WAIT_L
#undef PG8_BAR
#undef PG8_SCHED
}
}

#define LAS __attribute__((address_space(3)))
typedef unsigned short bf16;
typedef unsigned u32x4 __attribute__((ext_vector_type(4)));
typedef unsigned u32x2 __attribute__((ext_vector_type(2)));
typedef float f32x4 __attribute__((ext_vector_type(4)));
typedef float f32x16 __attribute__((ext_vector_type(16)));
typedef float f32x2 __attribute__((ext_vector_type(2)));
typedef short bf16x8 __attribute__((ext_vector_type(8)));
constexpr int NWAVES = 8;
constexpr int BATCH = 8, SEQ = 8192, DM = 1024, MTOK = BATCH * SEQ, FF = 4096, MEML = 256, MROWS = BATCH * MEML;
constexpr int IN_COLS = 5704, NQ = 2816, NG = 3072, NPROJ = NQ + NG;
constexpr int C_QA = 0, C_KA = 384, C_VA = 768, C_QB = 1152, C_KB = 1536, C_VB = 1664, C_QI = 1792, C_KI = 2304, C_WI = 2368, C_QC = 2376, C_GATE = 2632;
constexpr float EPS = 1e-6f;
constexpr size_t MiB = 1u << 20;
constexpr size_t WS_WIN = 0, WS_WMEM = 12 * MiB, WS_WA = 13 * MiB, WS_WB = 13 * MiB + 256 * 1024, WS_WC = 14 * MiB, WS_WO = 15 * MiB, WS_W1 = 17 * MiB, WS_W2 = 25 * MiB;
constexpr size_t WS_HM = 33 * MiB, WS_MKV = 37 * MiB, WS_H = 40 * MiB, WS_OA = 40 * MiB, WS_OB = 56 * MiB, WS_OC = 104 * MiB;
constexpr size_t WS_CTL = 39 * MiB, CTL_BYTES = 16384;
constexpr size_t WS_LISTS = 136 * MiB;
constexpr size_t WS_PQ = 168 * MiB, WS_G = 520 * MiB, WS_HID = 168 * MiB, WS_MERGED = 168 * MiB, WS_KIF = 904 * MiB, WS_CNT = 912 * MiB, WS_END = 913 * MiB;
constexpr int LDS_BYTES = 159744;
#define LDS_WAIT() asm volatile("s_waitcnt lgkmcnt(0)" ::: "memory")
#define LDS_ORDER() asm volatile("" ::: "memory")
#define MFMA32(a, b, c) __builtin_amdgcn_mfma_f32_32x32x16_bf16((a), (b), (c), 0, 0, 0)

__device__ __forceinline__ unsigned f2bf(float f) { unsigned u = __builtin_bit_cast(unsigned, f); return (u + 0x7fffu + ((u >> 16) & 1u)) >> 16; }
__device__ __forceinline__ unsigned pk2(float lo, float hi) { return f2bf(lo) | (f2bf(hi) << 16); }
__device__ __forceinline__ float bf2f(unsigned short h) { return __uint_as_float(((unsigned)h) << 16); }
__device__ __forceinline__ float wlo(unsigned w) { return __uint_as_float(w << 16); }
__device__ __forceinline__ float whi(unsigned w) { return __uint_as_float(w & 0xffff0000u); }
__device__ __forceinline__ int crow(int reg, int h) { return (reg & 3) + 8 * (reg >> 2) + 4 * h; }
__device__ __forceinline__ float wave_sum(float v) {
#pragma unroll
    for (int o = 1; o < 64; o <<= 1) v += __shfl_xor(v, o);
    return v;
}
__device__ __forceinline__ float wave_min(float v) {
#pragma unroll
    for (int o = 1; o < 64; o <<= 1) v = fminf(v, __shfl_xor(v, o));
    return v;
}
__device__ __forceinline__ float wave_max(float v) {
#pragma unroll
    for (int o = 1; o < 64; o <<= 1) v = fmaxf(v, __shfl_xor(v, o));
    return v;
}
__device__ __forceinline__ bf16x8 pack8(float a0, float a1, float a2, float a3, float a4, float a5, float a6, float a7) {
    u32x4 p; p.x = pk2(a0, a1); p.y = pk2(a2, a3); p.z = pk2(a4, a5); p.w = pk2(a6, a7); return __builtin_bit_cast(bf16x8, p);
}

__device__ __forceinline__ void transpose_item(const float* W, int K, int ldw, int c0, int nvalid, bf16* WT, int r0, int nblk, LAS float* scr, int item, int lane) {
    const int kb = item / nblk, nb = item % nblk, k0 = 64 * kb, n0 = 32 * nb;
    const int nn = n0 + (lane & 31); const bool ok = nn < nvalid;
#pragma unroll 8
    for (int i = 0; i < 32; ++i) { const int kk = 2 * i + (lane >> 5); scr[kk * 33 + (lane & 31)] = ok ? W[(size_t)(k0 + kk) * ldw + c0 + nn] : 0.f; }
    LDS_WAIT();
    const int c = lane & 7;
#pragma unroll
    for (int j = 0; j < 4; ++j) { const int n = (lane >> 3) + 8 * j; const LAS float* s = scr + (8 * c) * 33 + n;
        u32x4 o; o.x = pk2(s[0 * 33], s[1 * 33]); o.y = pk2(s[2 * 33], s[3 * 33]); o.z = pk2(s[4 * 33], s[5 * 33]); o.w = pk2(s[6 * 33], s[7 * 33]);
        *(u32x4*)(WT + (size_t)(r0 + n0 + n) * K + k0 + 8 * c) = o; }
    LDS_WAIT();
}
__device__ __forceinline__ void rms_row_to_bf16(const float* xrow, const float* g, bf16* orow, int lane) {
    const f32x4* xr = (const f32x4*)xrow + lane; const f32x4* gr = (const f32x4*)g + lane;
    f32x4 v[4]; float s = 0.f;
#pragma unroll
    for (int j = 0; j < 4; ++j) { v[j] = xr[64 * j]; s += (v[j].x * v[j].x + v[j].y * v[j].y) + (v[j].z * v[j].z + v[j].w * v[j].w); }
    const float rs = 1.0f / sqrtf(wave_sum(s) * (1.0f / 1024.0f) + EPS);
    u32x2* o8 = (u32x2*)orow + lane;
#pragma unroll
    for (int j = 0; j < 4; ++j) { const f32x4 gg = gr[64 * j]; u32x2 w; w.x = pk2(v[j].x * rs * gg.x, v[j].y * rs * gg.y); w.y = pk2(v[j].z * rs * gg.z, v[j].w * rs * gg.w); o8[64 * j] = w; }
}

struct Args { const float* in[20]; float* out; unsigned char* ws; int ph_lo, ph_hi; };
typedef const __attribute__((address_space(4))) Args* KArgs;

__device__ __forceinline__ void p0_prologue(KArgs a, LAS unsigned char* lds, int gw, int NGW, int wave, int lane) {
    LAS float* scr = (LAS float*)(lds + wave * 16384);
    unsigned char* ws = a->ws;
    constexpr int I0 = 16 * 88, I1 = 16 * 96, I2 = 16 * 16, I3 = 2 * 32, I4 = 6 * 32, I5 = 4 * 32, I6 = 16 * 32, I7 = 16 * 128, I8 = 64 * 32;
    constexpr int NITEMS = I0 + I1 + I2 + I3 + I4 + I5 + I6 + I7 + I8;
    for (int it = gw; it < NITEMS; it += NGW) {
        int r = it;
        if (r < I0) { transpose_item(a->in[5], 1024, IN_COLS, 0, C_GATE, (bf16*)(ws + WS_WIN), 0, 88, scr, r, lane); continue; } r -= I0;
        if (r < I1) { transpose_item(a->in[5], 1024, IN_COLS, C_GATE, NG, (bf16*)(ws + WS_WIN), NQ, 96, scr, r, lane); continue; } r -= I1;
        if (r < I2) { transpose_item(a->in[12], 1024, 512, 0, 512, (bf16*)(ws + WS_WMEM), 0, 16, scr, r, lane); continue; } r -= I2;
        if (r < I3) { transpose_item(a->in[13], 128, 1024, 0, 1024, (bf16*)(ws + WS_WA), 0, 32, scr, r, lane); continue; } r -= I3;
        if (r < I4) { transpose_item(a->in[14], 384, 1024, 0, 1024, (bf16*)(ws + WS_WB), 0, 32, scr, r, lane); continue; } r -= I4;
        if (r < I5) { transpose_item(a->in[15], 256, 1024, 0, 1024, (bf16*)(ws + WS_WC), 0, 32, scr, r, lane); continue; } r -= I5;
        if (r < I6) { transpose_item(a->in[16], 1024, 1024, 0, 1024, (bf16*)(ws + WS_WO), 0, 32, scr, r, lane); continue; } r -= I6;
        if (r < I7) { transpose_item(a->in[18], 1024, FF, 0, FF, (bf16*)(ws + WS_W1), 0, 128, scr, r, lane); continue; } r -= I7;
        transpose_item(a->in[19], FF, 1024, 0, 1024, (bf16*)(ws + WS_W2), 0, 32, scr, r, lane);
    }
    for (int m = gw; m < MTOK; m += NGW) rms_row_to_bf16(a->in[0] + (size_t)m * DM, a->in[3], (bf16*)(ws + WS_H) + (size_t)m * DM, lane);
    for (int m = gw; m < MROWS; m += NGW) rms_row_to_bf16(a->in[1] + (size_t)m * DM, a->in[4], (bf16*)(ws + WS_HM) + (size_t)m * DM, lane);
}

__device__ __forceinline__ void p2_normrot(KArgs a, int gw, int NGW, int lane) {
    bf16* Pq = (bf16*)(a->ws + WS_PQ); bf16* KIF = (bf16*)(a->ws + WS_KIF);
    const int* positions = (const int*)a->in[2];
    const int sub = lane & 7;
    int col0[5]; const float* gp[5]; bool rotf[5], actf[5];
#pragma unroll
    for (int rnd = 0; rnd < 5; ++rnd) {
        const int slot0 = rnd * 8 + (lane >> 3); actf[rnd] = slot0 < 33; const int s = actf[rnd] ? slot0 : 32;
        if (s < 6) { col0[rnd] = C_QA + 64 * s; gp[rnd] = a->in[6]; rotf[rnd] = true; }
        else if (s < 12) { col0[rnd] = C_KA + 64 * (s - 6); gp[rnd] = a->in[7]; rotf[rnd] = true; }
        else if (s < 18) { col0[rnd] = C_QB + 64 * (s - 12); gp[rnd] = a->in[8]; rotf[rnd] = true; }
        else if (s < 20) { col0[rnd] = C_KB + 64 * (s - 18); gp[rnd] = a->in[9]; rotf[rnd] = true; }
        else if (s < 28) { col0[rnd] = C_QI + 64 * (s - 20); gp[rnd] = nullptr; rotf[rnd] = true; }
        else if (s < 29) { col0[rnd] = C_KI; gp[rnd] = nullptr; rotf[rnd] = true; }
        else { col0[rnd] = C_QC + 64 * (s - 29); gp[rnd] = a->in[10]; rotf[rnd] = false; }
        col0[rnd] += 8 * sub;
    }
    u32x4 rawC[5], rawN[5]; int posC, posN;
    {
        const int t0_ = gw < MTOK ? gw : MTOK - 1;
#pragma unroll
        for (int rnd = 0; rnd < 5; ++rnd) rawC[rnd] = *(const u32x4*)(Pq + (size_t)t0_ * NQ + col0[rnd]);
        posC = positions[t0_];
    }
#pragma unroll 1
    for (int tok = gw; tok < MTOK; tok += NGW) {
        {
            const int tn = tok + NGW < MTOK ? tok + NGW : MTOK - 1;
#pragma unroll
            for (int rnd = 0; rnd < 5; ++rnd) rawN[rnd] = *(const u32x4*)(Pq + (size_t)tn * NQ + col0[rnd]);
            posN = positions[tn];
        }
        const float inv = __builtin_amdgcn_exp2f(-(float)sub * 2.3664460711f);
        const float ang = (float)posC * inv;
        const double rev = (double)ang * 0.15915494309189535; const float fr = (float)(rev - floor(rev));
        const float cs = __builtin_amdgcn_cosf(fr), sn = __builtin_amdgcn_sinf(fr);
        float ce[8], se[8];
#pragma unroll
        for (int e = 0; e < 8; ++e) { ce[e] = __shfl(cs, e); se[e] = __shfl(sn, e); }
        bf16* row = Pq + (size_t)tok * NQ;
#pragma unroll
        for (int rnd = 0; rnd < 5; ++rnd) {
            const u32x4 raw = rawC[rnd];
            float v[8] = {wlo(raw.x), whi(raw.x), wlo(raw.y), whi(raw.y), wlo(raw.z), whi(raw.z), wlo(raw.w), whi(raw.w)};
            float ss = 0.f;
#pragma unroll
            for (int e = 0; e < 8; ++e) ss += v[e] * v[e];
            ss += __shfl_xor(ss, 1); ss += __shfl_xor(ss, 2); ss += __shfl_xor(ss, 4);
            const float* g = gp[rnd];
            if (g) { const float rs = 1.0f / sqrtf(ss * (1.0f / 64.0f) + EPS); const f32x4 g0 = *(const f32x4*)(g + 8 * sub), g1 = *(const f32x4*)(g + 8 * sub + 4);
                v[0] *= rs * g0.x; v[1] *= rs * g0.y; v[2] *= rs * g0.z; v[3] *= rs * g0.w; v[4] *= rs * g1.x; v[5] *= rs * g1.y; v[6] *= rs * g1.z; v[7] *= rs * g1.w; }
            float ot[8];
#pragma unroll
            for (int e = 0; e < 8; ++e) ot[e] = __shfl_xor(v[e], 1);
            if (rotf[rnd] && sub < 2) {
                const float sg = sub == 0 ? -1.f : 1.f;
#pragma unroll
                for (int e = 0; e < 8; ++e) v[e] = v[e] * ce[e] + sg * ot[e] * se[e];
            }
            if (actf[rnd]) { u32x4 o; o.x = pk2(v[0], v[1]); o.y = pk2(v[2], v[3]); o.z = pk2(v[4], v[5]); o.w = pk2(v[6], v[7]); *(u32x4*)(row + col0[rnd]) = o;
                if (rnd == 3 && (lane >> 3) == 4) {
                    const int tb_ = tok >> 5, n_ = tok & 31, ks_ = sub >> 1, hi_ = sub & 1;
                    *(u32x4*)(KIF + ((((size_t)tb_ * 4 + ks_) * 2 + hi_) * 32 + n_) * 8) = o; } }
        }
#pragma unroll
        for (int rnd = 0; rnd < 5; ++rnd) rawC[rnd] = rawN[rnd];
        posC = posN;
    }
    bf16* MKV = (bf16*)(a->ws + WS_MKV);
    for (int it = gw; it < MROWS / 2; it += NGW) {
        const int row = 2 * it + (lane >> 5), slot = (lane >> 3) & 3;
        u32x4* p = (u32x4*)(MKV + (size_t)row * 512 + slot * 64 + 8 * sub);
        const u32x4 raw = *p;
        float v[8] = {wlo(raw.x), whi(raw.x), wlo(raw.y), whi(raw.y), wlo(raw.z), whi(raw.z), wlo(raw.w), whi(raw.w)};
        float ss = 0.f;
#pragma unroll
        for (int e = 0; e < 8; ++e) ss += v[e] * v[e];
        ss += __shfl_xor(ss, 1); ss += __shfl_xor(ss, 2); ss += __shfl_xor(ss, 4);
        const float rs = 1.0f / sqrtf(ss * (1.0f / 64.0f) + EPS); const float* g = a->in[11];
        const f32x4 g0 = *(const f32x4*)(g + 8 * sub), g1 = *(const f32x4*)(g + 8 * sub + 4);
        u32x4 o; o.x = pk2(v[0] * rs * g0.x, v[1] * rs * g0.y); o.y = pk2(v[2] * rs * g0.z, v[3] * rs * g0.w); o.z = pk2(v[4] * rs * g1.x, v[5] * rs * g1.y); o.w = pk2(v[6] * rs * g1.z, v[7] * rs * g1.w);
        *p = o;
    }
}

typedef short s16x4e __attribute__((ext_vector_type(4)));
__device__ __forceinline__ s16x4e lds_tr16e(const LAS unsigned char* p) { return __builtin_bit_cast(s16x4e, __builtin_amdgcn_ds_read_tr16_b64_v4i16((LAS s16x4e*)p)); }
constexpr int KROWE = 144, VROWE = 192;
__device__ __forceinline__ void dilated_unit(LAS unsigned char* wl, const bf16* Pq, bf16* OA, int b, int hh, int tb, int r, int lane) {
    const int qi = lane & 31, hi = lane >> 5;
    const int r8 = lane >> 3, ch8 = lane & 7;
    LAS unsigned char* kwr = wl + r8 * KROWE + ch8 * 16; LAS unsigned char* vwr = wl + 4608 + r8 * VROWE + ch8 * 16;
    const LAS unsigned char* krd = wl + qi * KROWE + hi * 16;
    const LAS unsigned char* vrd = wl + 4608 + (4 * hi + ((lane & 15) >> 2)) * VROWE + (((lane >> 4) & 1) * 16 + 4 * (lane & 3)) * 2;
    const int t_q = tb * 512 + r + 16 * qi;
    const size_t rowb = (size_t)b * SEQ;
    f32x16 o0, o1;
#pragma unroll
    for (int i = 0; i < 16; ++i) { o0[i] = 0.f; o1[i] = 0.f; }
    float l = 0.f;
#pragma unroll 1
    for (int g = 0; g < 3; ++g) {
        const int dl = 2 * g, dil = 1 << dl, rho = r & (dil - 1), head = 2 * g + hh;
        const int step = 16 >> dl, m_q = t_q >> dl, m0 = (tb * 512 + r) >> dl, kstart = m0 - 128, mmax = (SEQ >> dl) - 1;
        const int nblk = (129 + 31 * step + 31) >> 5;
        bf16x8 qf[4];
#pragma unroll
        for (int ks = 0; ks < 4; ++ks) qf[ks] = *(const bf16x8*)(Pq + (rowb + t_q) * NQ + C_QA + head * 64 + 16 * ks + 8 * hi);
        u32x4 kgA[4], kgB[4], vgA[4], vgB[4];
#define DL_LOAD(kg_, vg_, kb_) do { const int kbase_ = kstart + 32 * (kb_); \
            _Pragma("unroll") for (int i = 0; i < 4; ++i) { int mk_ = kbase_ + 8 * i + r8; mk_ = mk_ < 0 ? 0 : (mk_ > mmax ? mmax : mk_); \
                const bf16* row_ = Pq + (rowb + ((size_t)mk_ << dl) + rho) * NQ + head * 64 + ch8 * 8; \
                kg_[i] = *(const u32x4*)(row_ + C_KA); vg_[i] = *(const u32x4*)(row_ + C_VA); } } while (0)
#define DL_COMP(kg_, vg_, kb_) do { const int kbase_ = kstart + 32 * (kb_); \
            _Pragma("unroll") for (int i = 0; i < 4; ++i) { *(LAS u32x4*)(kwr + 8 * i * KROWE) = kg_[i]; *(LAS u32x4*)(vwr + 8 * i * VROWE) = vg_[i]; } \
            LDS_ORDER(); \
            f32x16 s_; \
            _Pragma("unroll") for (int i = 0; i < 16; ++i) s_[i] = 0.f; \
            _Pragma("unroll") for (int ks = 0; ks < 4; ++ks) { const bf16x8 kf_ = *(const LAS bf16x8*)(krd + ks * 32); s_ = MFMA32(kf_, qf[ks], s_); } \
            float p_[16]; \
            _Pragma("unroll") for (int i = 0; i < 16; ++i) { const int mka = kbase_ + crow(i, hi); const int dist = m_q - mka; const bool ok = (dist >= 0) && (dist <= 128) && (mka >= 0); \
                p_[i] = ok ? __expf(s_[i] * 0.125f) : 0.f; l += p_[i]; } \
            _Pragma("unroll") for (int st = 0; st < 2; ++st) { \
                const bf16x8 pb = pack8(p_[8 * st + 0], p_[8 * st + 1], p_[8 * st + 2], p_[8 * st + 3], p_[8 * st + 4], p_[8 * st + 5], p_[8 * st + 6], p_[8 * st + 7]); \
                const s16x4e l0_ = lds_tr16e(vrd + st * 16 * VROWE), h0_ = lds_tr16e(vrd + (st * 16 + 8) * VROWE), l1_ = lds_tr16e(vrd + st * 16 * VROWE + 64), h1_ = lds_tr16e(vrd + (st * 16 + 8) * VROWE + 64); \
                o0 = MFMA32(((bf16x8){l0_[0], l0_[1], l0_[2], l0_[3], h0_[0], h0_[1], h0_[2], h0_[3]}), pb, o0); \
                o1 = MFMA32(((bf16x8){l1_[0], l1_[1], l1_[2], l1_[3], h1_[0], h1_[1], h1_[2], h1_[3]}), pb, o1); } \
            LDS_ORDER(); } while (0)
        const int lastk = nblk - 1;
        DL_LOAD(kgA, vgA, 0);
#pragma unroll 1
        for (int kb = 0; kb < nblk; kb += 2) {
            DL_LOAD(kgB, vgB, (kb + 1 < lastk ? kb + 1 : lastk));
            DL_COMP(kgA, vgA, kb);
            DL_LOAD(kgA, vgA, (kb + 2 < lastk ? kb + 2 : lastk));
            if (kb + 1 < nblk) DL_COMP(kgB, vgB, kb + 1);
        }
#undef DL_LOAD
#undef DL_COMP
    }
    l += __shfl_xor(l, 32);
    const float inv = 1.0f / l;
    bf16* orow = OA + (rowb + t_q) * 128 + hh * 64;
#pragma unroll
    for (int g4 = 0; g4 < 4; ++g4) {
        u32x2 w0, w1; w0.x = pk2(o0[4 * g4] * inv, o0[4 * g4 + 1] * inv); w0.y = pk2(o0[4 * g4 + 2] * inv, o0[4 * g4 + 3] * inv);
        w1.x = pk2(o1[4 * g4] * inv, o1[4 * g4 + 1] * inv); w1.y = pk2(o1[4 * g4 + 2] * inv, o1[4 * g4 + 3] * inv);
        *(u32x2*)(orow + 8 * g4 + 4 * hi) = w0; *(u32x2*)(orow + 32 + 8 * g4 + 4 * hi) = w1;
    }
}

__device__ __forceinline__ void mem_unit(LAS unsigned char* wl, const bf16* Pq, const bf16* MKV, bf16* OC, int b, int head, int qb, int lane) {
    const int qi = lane & 31, hi = lane >> 5;
    const int r8 = lane >> 3, ch8 = lane & 7;
    LAS unsigned char* kwr = wl + r8 * KROWE + ch8 * 16; LAS unsigned char* vwr = wl + 4608 + r8 * VROWE + ch8 * 16;
    const LAS unsigned char* krd = wl + qi * KROWE + hi * 16;
    const LAS unsigned char* vrd = wl + 4608 + (4 * hi + ((lane & 15) >> 2)) * VROWE + (((lane >> 4) & 1) * 16 + 4 * (lane & 3)) * 2;
    const size_t tokrow = (size_t)b * SEQ + qb * 32 + qi;
    bf16x8 qf[4];
#pragma unroll
    for (int ks = 0; ks < 4; ++ks) qf[ks] = *(const bf16x8*)(Pq + tokrow * NQ + C_QC + head * 64 + 16 * ks + 8 * hi);
    f32x16 o0, o1;
#pragma unroll
    for (int i = 0; i < 16; ++i) { o0[i] = 0.f; o1[i] = 0.f; }
    float l = 0.f;
    const bf16* Mb = MKV + (size_t)b * MEML * 512;
    u32x4 kgA[4], kgB[4], vgA[4], vgB[4];
#define MM_LOAD(kg_, vg_, kb_) do { _Pragma("unroll") for (int i = 0; i < 4; ++i) { const bf16* row_ = Mb + (size_t)(32 * (kb_) + 8 * i + r8) * 512 + head * 64 + ch8 * 8; \
        kg_[i] = *(const u32x4*)(row_); vg_[i] = *(const u32x4*)(row_ + 256); } } while (0)
#define MM_COMP(kg_, vg_) do { \
        _Pragma("unroll") for (int i = 0; i < 4; ++i) { *(LAS u32x4*)(kwr + 8 * i * KROWE) = kg_[i]; *(LAS u32x4*)(vwr + 8 * i * VROWE) = vg_[i]; } \
        LDS_ORDER(); \
        f32x16 s_; \
        _Pragma("unroll") for (int i = 0; i < 16; ++i) s_[i] = 0.f; \
        _Pragma("unroll") for (int ks = 0; ks < 4; ++ks) { const bf16x8 kf_ = *(const LAS bf16x8*)(krd + ks * 32); s_ = MFMA32(kf_, qf[ks], s_); } \
        float p_[16]; \
        _Pragma("unroll") for (int i = 0; i < 16; ++i) { p_[i] = __expf(s_[i] * 0.125f); l += p_[i]; } \
        _Pragma("unroll") for (int st = 0; st < 2; ++st) { \
            const bf16x8 pb = pack8(p_[8 * st + 0], p_[8 * st + 1], p_[8 * st + 2], p_[8 * st + 3], p_[8 * st + 4], p_[8 * st + 5], p_[8 * st + 6], p_[8 * st + 7]); \
            const s16x4e l0_ = lds_tr16e(vrd + st * 16 * VROWE), h0_ = lds_tr16e(vrd + (st * 16 + 8) * VROWE), l1_ = lds_tr16e(vrd + st * 16 * VROWE + 64), h1_ = lds_tr16e(vrd + (st * 16 + 8) * VROWE + 64); \
            o0 = MFMA32(((bf16x8){l0_[0], l0_[1], l0_[2], l0_[3], h0_[0], h0_[1], h0_[2], h0_[3]}), pb, o0); \
            o1 = MFMA32(((bf16x8){l1_[0], l1_[1], l1_[2], l1_[3], h1_[0], h1_[1], h1_[2], h1_[3]}), pb, o1); } \
        LDS_ORDER(); } while (0)
    MM_LOAD(kgA, vgA, 0);
#pragma unroll 1
    for (int kb = 0; kb < 8; kb += 2) {
        MM_LOAD(kgB, vgB, kb + 1);
        MM_COMP(kgA, vgA);
        MM_LOAD(kgA, vgA, (kb + 2 < 7 ? kb + 2 : 7));
        MM_COMP(kgB, vgB);
    }
#undef MM_LOAD
#undef MM_COMP
    l += __shfl_xor(l, 32);
    const float inv = 1.0f / l;
    bf16* orow = OC + tokrow * 256 + head * 64;
#pragma unroll
    for (int g4 = 0; g4 < 4; ++g4) {
        u32x2 w0, w1; w0.x = pk2(o0[4 * g4] * inv, o0[4 * g4 + 1] * inv); w0.y = pk2(o0[4 * g4 + 2] * inv, o0[4 * g4 + 3] * inv);
        w1.x = pk2(o1[4 * g4] * inv, o1[4 * g4 + 1] * inv); w1.y = pk2(o1[4 * g4 + 2] * inv, o1[4 * g4 + 3] * inv);
        *(u32x2*)(orow + 8 * g4 + 4 * hi) = w0; *(u32x2*)(orow + 32 + 8 * g4 + 4 * hi) = w1;
    }
}

__device__ __forceinline__ int hist_find9(const LAS unsigned* h, int K, int lane, int& above_out) {
    const u32x4 ha = *(const LAS u32x4*)(h + 8 * lane), hb = *(const LAS u32x4*)(h + 8 * lane + 4);
    const int cnt[8] = {(int)ha.x, (int)ha.y, (int)ha.z, (int)ha.w, (int)hb.x, (int)hb.y, (int)hb.z, (int)hb.w};
    int tot = 0;
#pragma unroll
    for (int i = 0; i < 8; ++i) tot += cnt[i];
    int suf = tot;
#pragma unroll
    for (int off = 1; off < 64; off <<= 1) { const int t = __shfl_down(suf, off); if (lane + off < 64) suf += t; }
    const int above = suf - tot;
    const bool pred = (above < K) && (suf >= K);
    int bin = 8 * lane, abv = above, c = above; bool found = false;
#pragma unroll
    for (int i = 7; i >= 0; --i) { if (!found) { if (c + cnt[i] >= K) { bin = 8 * lane + i; abv = c; found = true; } else c += cnt[i]; } }
    const unsigned long long bal = __ballot(pred);
    const int src = bal ? (int)__ffsll((long long)bal) - 1 : 0;
    above_out = __shfl(abv, src);
    return __shfl(bin, src);
}

typedef _Float16 h16x8 __attribute__((ext_vector_type(8)));
constexpr int SB_SC = 0, SB_HIST = 131072, SB_CANDV = 147456, SB_CANDI = 151552, SB_MM = 155648;
constexpr int CCAP = 256;
__device__ __forceinline__ void dsa_select_phase(LAS unsigned char* lds, const bf16* Pq, const bf16* KIF, unsigned short* LISTS, unsigned short* CNT, int G, int bid, int wave, int lane_in) {
    LAS _Float16* sc = (LAS _Float16*)(lds + SB_SC);
    LAS unsigned* hist = (LAS unsigned*)(lds + SB_HIST);
    LAS _Float16* candv = (LAS _Float16*)(lds + SB_CANDV);
    LAS unsigned short* candi = (LAS unsigned short*)(lds + SB_CANDI);
    LAS float* mm = (LAS float*)(lds + SB_MM);
    const int q = wave;
    LAS _Float16* myS = sc + q * 8192;
    LAS unsigned* myHist = hist + q * 512;
    LAS _Float16* myCv = candv + q * CCAP; LAS unsigned short* myCi = candi + q * CCAP;
#pragma unroll 1
    for (int u = bid; u < MTOK / 8; u += G) {
        const int b = u & 7, t0 = (u >> 3) * 8;
        const size_t rowb = (size_t)b * SEQ;
        {
            int lane = lane_in; asm volatile("" : "+v"(lane));
            const int m = lane & 31, hi = lane >> 5;
            const int qq = ((m >> 2) & 1) * 2 + (m >> 4), hh = ((m >> 3) & 1) * 4 + (m & 3);
            bf16x8 qfA[4], qfB[4];
#pragma unroll
            for (int ks = 0; ks < 4; ++ks) { qfA[ks] = *(const bf16x8*)(Pq + (rowb + t0 + qq) * NQ + C_QI + hh * 64 + 16 * ks + 8 * hi); qfB[ks] = *(const bf16x8*)(Pq + (rowb + t0 + 4 + qq) * NQ + C_QI + hh * 64 + 16 * ks + 8 * hi); }
            const float WS = 0.04419417382415922f;
            f32x2 wv[4][4];
#pragma unroll
            for (int j = 0; j < 4; ++j) { const u32x4 wr_ = *(const u32x4*)(Pq + (rowb + t0 + (j >> 1) * 4 + 2 * hi + (j & 1)) * NQ + C_WI);
                wv[j][0] = (f32x2){wlo(wr_.x) * WS, whi(wr_.x) * WS}; wv[j][1] = (f32x2){wlo(wr_.y) * WS, whi(wr_.y) * WS}; wv[j][2] = (f32x2){wlo(wr_.z) * WS, whi(wr_.z) * WS}; wv[j][3] = (f32x2){wlo(wr_.w) * WS, whi(wr_.w) * WS}; }
            const int npp = (t0 + 8 + 63) >> 6;
            const bf16* kbase = KIF + (size_t)b * (SEQ * 64) + lane * 8;
            bf16x8 k0[2][4], k1[2][4];
#define SC_LOAD(buf, pp_) do { _Pragma("unroll") for (int h2 = 0; h2 < 2; ++h2) _Pragma("unroll") for (int ks = 0; ks < 4; ++ks) \
                buf[h2][ks] = *(const bf16x8*)(kbase + (size_t)((2 * (pp_) + h2) * 4 + ks) * 512); } while (0)
#define SC_TILE(qf_, j0_, qofs_, buf_, h2_) do { f32x16 acc; \
                _Pragma("unroll") for (int i = 0; i < 16; ++i) acc[i] = 0.f; \
                _Pragma("unroll") for (int ks = 0; ks < 4; ++ks) acc = MFMA32(qf_[ks], buf_[h2_][ks], acc); \
                f32x2 a0 = {0.f, 0.f}, a1 = {0.f, 0.f}; \
                _Pragma("unroll") for (int i = 0; i < 4; ++i) { \
                    const f32x2 r0 = {__builtin_amdgcn_fmed3f(acc[2 * i], 0.f, INFINITY), __builtin_amdgcn_fmed3f(acc[2 * i + 1], 0.f, INFINITY)}; \
                    const f32x2 r1 = {__builtin_amdgcn_fmed3f(acc[8 + 2 * i], 0.f, INFINITY), __builtin_amdgcn_fmed3f(acc[9 + 2 * i], 0.f, INFINITY)}; \
                    a0 = wv[j0_][i] * r0 + a0; a1 = wv[j0_ + 1][i] * r1 + a1; } \
                const _Float16 h0 = (_Float16)(a0.x + a0.y), h1 = (_Float16)(a1.x + a1.y);     \
                sc[(qofs_ + 2 * hi) * 8192 + key] = h0; sc[(qofs_ + 2 * hi + 1) * 8192 + key] = h1; } while (0)
#define SC_COMP(buf, pp_) do { _Pragma("unroll") for (int h2 = 0; h2 < 2; ++h2) { const int key = 64 * (pp_) + 32 * h2 + m; SC_TILE(qfA, 0, 0, buf, h2); SC_TILE(qfB, 2, 4, buf, h2); } } while (0)
            const int lastp = npp - 1;
            SC_LOAD(k0, (wave < lastp ? wave : lastp));
#pragma unroll 1
            for (int pp = wave; pp < npp; pp += 16) {
                SC_LOAD(k1, (pp + 8 < lastp ? pp + 8 : lastp));
                SC_COMP(k0, pp);
                SC_LOAD(k0, (pp + 16 < lastp ? pp + 16 : lastp));
                if (pp + 8 < npp) SC_COMP(k1, pp + 8);
            }
#undef SC_LOAD
#undef SC_TILE
#undef SC_COMP
            *(LAS u32x4*)(myHist + 8 * lane) = (u32x4){0u, 0u, 0u, 0u}; *(LAS u32x4*)(myHist + 8 * lane + 4) = (u32x4){0u, 0u, 0u, 0u};
        }
        __syncthreads();
        const int tq = t0 + q, nk = tq + 1;
        {
            int lane = lane_in; asm volatile("" : "+v"(lane));
            const unsigned long long lt_mask = (1ull << lane) - 1ull;
            unsigned short* drow = LISTS + (size_t)(rowb + tq) * 256;
            int nsel = 0;
            if (t0 + 8 <= 256) {
#pragma unroll 1
                for (int c = 0; c * 64 < nk; ++c) { const int e = c * 64 + lane; if (e < nk) drow[e] = (unsigned short)e; }
                nsel = nk;
            } else {
                float lo, hv;
                {
                    h16x8 vmn, vmx;
#pragma unroll
                    for (int i = 0; i < 8; ++i) { vmn[i] = (_Float16)INFINITY; vmx[i] = (_Float16)(-INFINITY); }
                    int cb = 0;
#pragma unroll 1
                    for (; cb + 512 <= nk; cb += 512) { const h16x8 v = *(const LAS h16x8*)(myS + cb + 8 * lane); vmn = __builtin_elementwise_min(vmn, v); vmx = __builtin_elementwise_max(vmx, v); }
                    if (cb < nk) { const h16x8 v = *(const LAS h16x8*)(myS + cb + 8 * lane);
#pragma unroll
                        for (int i = 0; i < 8; ++i) if (cb + 8 * lane + i < nk) { vmn[i] = vmn[i] < v[i] ? vmn[i] : v[i]; vmx[i] = vmx[i] > v[i] ? vmx[i] : v[i]; } }
                    float a = (float)vmn[0], bmx = (float)vmx[0];
#pragma unroll
                    for (int i = 1; i < 8; ++i) { a = fminf(a, (float)vmn[i]); bmx = fmaxf(bmx, (float)vmx[i]); }
                    lo = wave_min(a); hv = wave_max(bmx);
                }
                const float scale = (hv > lo) ? 511.0f / (hv - lo) : 0.f;
                {
                    int cb = 0;
#pragma unroll 1
                    for (; cb + 512 <= nk; cb += 512) {
                        const h16x8 v = *(const LAS h16x8*)(myS + cb + 8 * lane);
#pragma unroll
                        for (int i = 0; i < 8; ++i) { const unsigned k = (unsigned)fminf(((float)v[i] - lo) * scale, 511.0f); atomicAdd((unsigned*)&myHist[k], 1u); }
                    }
                    if (cb < nk) {
                        const h16x8 v = *(const LAS h16x8*)(myS + cb + 8 * lane);
#pragma unroll
                        for (int i = 0; i < 8; ++i) if (cb + 8 * lane + i < nk) { const unsigned k = (unsigned)fminf(((float)v[i] - lo) * scale, 511.0f); atomicAdd((unsigned*)&myHist[k], 1u); }
                    }
                }
                LDS_WAIT();
                int abv1; const int T = hist_find9(myHist, 256, lane, abv1);
                const int rem2 = 256 - abv1;
                const float Tf = (float)T, Tp1 = (float)(T + 1);
                int ncand = 0;
#pragma unroll 1
                for (int cb = 0; cb < nk; cb += 512) {
                    const h16x8 v = *(const LAS h16x8*)(myS + cb + 8 * lane);
                    const bool full = cb + 512 <= nk;
#pragma unroll
                    for (int i = 0; i < 8; ++i) {
                        const int e = cb + 8 * lane + i; const float vf = (float)v[i]; const float x = (vf - lo) * scale; const bool ok = full || e < nk;
                        const bool sel = ok && x >= Tp1, cnd = ok && x >= Tf && !(x >= Tp1);
                        const unsigned long long ms = __ballot(sel), mc = __ballot(cnd);
                        if (sel) { const int pos = nsel + __popcll(ms & lt_mask); if (pos < 256) drow[pos] = (unsigned short)e; }
                        nsel += __popcll(ms);
                        if (mc) {
                            if (cnd) { const int pos = ncand + __popcll(mc & lt_mask); if (pos < CCAP) { myCv[pos] = v[i]; myCi[pos] = (unsigned short)e; } }
                            ncand += __popcll(mc);
                        }
                    }
                }
                if (ncand > CCAP) ncand = CCAP;
                LDS_WAIT();
#pragma unroll 1
                for (int c0 = 0; c0 < ncand; c0 += 64) {
                    const int ci = c0 + lane; const bool have = ci < ncand;
                    const float vi = have ? (float)myCv[ci] : 0.f; const int ii = have ? (int)myCi[ci] : 0;
                    int rank = 0;
#pragma unroll 1
                    for (int j = 0; j < ncand; ++j) { const float vj = (float)myCv[j]; const int ij = (int)myCi[j]; rank += (vj > vi || (vj == vi && ij < ii)) ? 1 : 0; }
                    const bool sel = have && rank < rem2;
                    const unsigned long long ms = __ballot(sel);
                    if (sel) { const int pos = nsel + __popcll(ms & lt_mask); if (pos < 256) drow[pos] = (unsigned short)ii; }
                    nsel += __popcll(ms);
                }
                if (nsel > 256) nsel = 256;
            }
            if (lane == 0) CNT[rowb + tq] = (unsigned short)nsel;
        }
        __syncthreads();
    }
}

typedef short s16x4 __attribute__((ext_vector_type(4)));
__device__ __forceinline__ s16x4 lds_tr16(const LAS unsigned char* p) { return __builtin_bit_cast(s16x4, __builtin_amdgcn_ds_read_tr16_b64_v4i16((LAS s16x4*)p)); }
constexpr int KROW = 144;
constexpr int VROW = 192;
__device__ __forceinline__ void dsa_attn_phase(LAS unsigned char* lds, const bf16* Pq, const unsigned short* LISTS, const unsigned short* CNT, bf16* OB, int bid, int wave, int lane_in) {
    LAS unsigned char* Vst = lds + wave * 16384;
    LAS unsigned short* Pst = (LAS unsigned short*)(lds + wave * 16384 + 6144);
    LAS unsigned short* myList = (LAS unsigned short*)(lds + wave * 16384 + 6400);
    LAS unsigned char* qst = lds + wave * 16384 + 6912;
    LAS unsigned char* Kst = lds + wave * 16384 + 7424;
    const int b = bid & 7, widx = (bid >> 3) * 8 + wave;
    const size_t rowb = (size_t)b * SEQ;
#pragma unroll 1
    for (int tq = widx; tq < SEQ; tq += 256) {
        int nsel = (int)CNT[rowb + tq]; nsel = nsel < 1 ? 1 : (nsel > 256 ? 256 : nsel); nsel = __builtin_amdgcn_readfirstlane(nsel);
#pragma unroll 1
    for (int c = 0; c < 2; ++c) {
        int lane = lane_in; asm volatile("" : "+v"(lane));
        {
            if (c == 0) {
            const u32x2 lw = *(const u32x2*)(LISTS + (rowb + tq) * 256 + 4 * lane);
            unsigned e0 = lw.x & 0xffffu, e1 = lw.x >> 16, e2 = lw.y & 0xffffu, e3 = lw.y >> 16;
            e0 = e0 > (unsigned)tq ? (unsigned)tq : e0; e1 = e1 > (unsigned)tq ? (unsigned)tq : e1; e2 = e2 > (unsigned)tq ? (unsigned)tq : e2; e3 = e3 > (unsigned)tq ? (unsigned)tq : e3;
            *(LAS u32x2*)(myList + 4 * lane) = (u32x2){e0 | (e1 << 16), e2 | (e3 << 16)};
            }
            if (lane < 32) {
                const int h = lane >> 3, chn = lane & 7;
                const u32x4 qv = lane < 24 ? *(const u32x4*)(Pq + (rowb + tq) * NQ + C_QB + (3 * c + h) * 64 + chn * 8) : (u32x4){0u, 0u, 0u, 0u};
                const int qoff = lane < 24 ? (chn * 64 + h * 16) : ((lane - 24) * 64 + 48);
                *(LAS u32x4*)(qst + qoff) = qv;
            }
        }
        LDS_WAIT();
        const int m = lane & 31, hi = lane >> 5;
        const int r8 = lane >> 3, ch8 = lane & 7;
        f32x16 O0, O1;
#pragma unroll
        for (int i = 0; i < 16; ++i) { O0[i] = 0.f; O1[i] = 0.f; }
        float lp[3] = {0.f, 0.f, 0.f};
        const int nbk = (nsel + 31) >> 5;
        const bf16* kbase = Pq + rowb * NQ + C_KB + c * 64 + ch8 * 8;
        const bf16* vbase = Pq + rowb * NQ + C_VB + c * 64 + ch8 * 8;
        const LAS unsigned char* qrd = qst + hi * 64 + (m < 3 ? m : 3) * 16;
        const LAS unsigned char* prd = (const LAS unsigned char*)Pst + (m < 3 ? m : 2) * 64 + 8 * hi;
        const LAS unsigned char* vrd = Vst + (4 * hi + ((lane & 15) >> 2)) * VROW + (((lane >> 4) & 1) * 16 + 4 * (lane & 3)) * 2;
        LAS unsigned char* vwr = Vst + r8 * VROW + ch8 * 16;
        LAS unsigned char* kwr = Kst + r8 * KROW + ch8 * 16;
        const LAS unsigned char* krd = Kst + m * KROW + hi * 16;
        u32x4 kA[4], kB[4], kC[4]; u32x4 vA[4], vB[4], vC[4];
#define KV_LOAD(kbuf, vbuf, bk_) do { _Pragma("unroll") for (int i = 0; i < 4; ++i) { const int jj_ = 32 * (bk_) + 8 * i + r8; const int key_ = (int)myList[jj_ < 256 ? jj_ : 255]; \
            kbuf[i] = *(const u32x4*)(kbase + (size_t)key_ * NQ); vbuf[i] = *(const u32x4*)(vbase + (size_t)key_ * NQ); } } while (0)
#define BLOCK(kbuf, vbuf, bk_) do { \
            _Pragma("unroll") for (int i = 0; i < 4; ++i) { *(LAS u32x4*)(vwr + 8 * i * VROW) = vbuf[i]; *(LAS u32x4*)(kwr + 8 * i * KROW) = kbuf[i]; } \
            LDS_ORDER(); \
            { f32x16 sacc; \
                _Pragma("unroll") for (int i = 0; i < 16; ++i) sacc[i] = 0.f; \
                _Pragma("unroll") for (int ks = 0; ks < 4; ++ks) { const bf16x8 qa = *(const LAS bf16x8*)(qrd + ks * 128); const bf16x8 kf = *(const LAS bf16x8*)(krd + ks * 32); sacc = MFMA32(qa, kf, sacc); } \
                const bool pv_ = (lane < 32) && (32 * (bk_) + m < nsel); \
                _Pragma("unroll") for (int g = 0; g < 3; ++g) { const float p = pv_ ? __expf(sacc[g] * 0.125f) : 0.f; lp[g] += p; if (lane < 32) Pst[g * 32 + m] = (unsigned short)f2bf(p); } } \
            LDS_ORDER(); \
            _Pragma("unroll") for (int s2 = 0; s2 < 2; ++s2) { \
                const u32x2 pl = *(const LAS u32x2*)(prd + s2 * 32), ph = *(const LAS u32x2*)(prd + s2 * 32 + 16); \
                const bf16x8 pb = __builtin_bit_cast(bf16x8, (u32x4){pl.x, pl.y, ph.x, ph.y}); \
                _Pragma("unroll") for (int db = 0; db < 2; ++db) { \
                    const s16x4 vl = lds_tr16(vrd + s2 * 16 * VROW + db * 64), vh = lds_tr16(vrd + (s2 * 16 + 8) * VROW + db * 64); \
                    const bf16x8 va = (bf16x8){vl[0], vl[1], vl[2], vl[3], vh[0], vh[1], vh[2], vh[3]}; \
                    if (db == 0) O0 = MFMA32(va, pb, O0); else O1 = MFMA32(va, pb, O1); } } \
            LDS_ORDER(); } while (0)
        KV_LOAD(kA, vA, 0);
        KV_LOAD(kB, vB, 1);
#pragma unroll 1
        for (int bk = 0; bk < nbk; bk += 3) {
            KV_LOAD(kC, vC, bk + 2);
            BLOCK(kA, vA, bk);
            KV_LOAD(kA, vA, bk + 3);
            if (bk + 1 < nbk) BLOCK(kB, vB, bk + 1);
            KV_LOAD(kB, vB, bk + 4);
            if (bk + 2 < nbk) BLOCK(kC, vC, bk + 2);
        }
#undef KV_LOAD
#undef BLOCK
#pragma unroll
        for (int h = 0; h < 3; ++h) lp[h] = wave_sum(lp[h]);
        if (m < 3) {
            const float l0 = m == 0 ? lp[0] : (m == 1 ? lp[1] : lp[2]);
            const float i0 = 1.0f / l0;
            bf16* o0 = OB + (rowb + tq) * 384 + (3 * c + m) * 64 + 4 * hi;
#pragma unroll
            for (int g4 = 0; g4 < 4; ++g4) {
                u32x2 w;
                w.x = pk2(O0[4 * g4] * i0, O0[4 * g4 + 1] * i0); w.y = pk2(O0[4 * g4 + 2] * i0, O0[4 * g4 + 3] * i0); *(u32x2*)(o0 + 8 * g4) = w;
                w.x = pk2(O1[4 * g4] * i0, O1[4 * g4 + 1] * i0); w.y = pk2(O1[4 * g4 + 2] * i0, O1[4 * g4 + 3] * i0); *(u32x2*)(o0 + 32 + 8 * g4) = w;
            }
        }
        LDS_WAIT();
    }
    }
}

#define XB_TMO      128
#define XB_XCNT(j)  (256  + 64 * (j))
#define XB_XSUB(j)  (1280 + 64 * (j))
#define XB_XGEN(j)  (2304 + 64 * (j))
#define XB_TOP      3328
#define XB_TOPGEN   3392
#define XCD_BAR_WORDS 3456
#define XB_SPIN_CAP (1u << 18)

__device__ __forceinline__ unsigned xb_ld(unsigned* p)              { return __hip_atomic_load(p, __ATOMIC_RELAXED, __HIP_MEMORY_SCOPE_AGENT); }
__device__ __forceinline__ unsigned xb_add(unsigned* p, unsigned v) { return __hip_atomic_fetch_add(p, v, __ATOMIC_RELAXED, __HIP_MEMORY_SCOPE_AGENT); }
__device__ __forceinline__ unsigned xb_xcc_id() { return (unsigned)__builtin_amdgcn_s_getreg((3 << 11) | 20) & 0xFu; }
#define XB_SPIN(cond, bar) do { unsigned _sp = 0; while (cond) { __builtin_amdgcn_s_sleep(1); \
    if ((++_sp & 255u) == 0u) { if (xb_ld(&(bar)[XB_TMO])) break; if (_sp > XB_SPIN_CAP) { atomicAdd(&(bar)[XB_TMO], 1u); break; } } } } while (0)

struct XcdBarrier {
    unsigned* bar; unsigned x;
    volatile LAS unsigned* st;
};

__device__ __forceinline__ XcdBarrier xcd_barrier_post(unsigned* bar, volatile LAS unsigned* st) {
    XcdBarrier b; b.bar = bar; b.x = xb_xcc_id(); b.st = st;
    if (threadIdx.x == 0) (void)xb_add(&bar[XB_XCNT(b.x)], 1u);
    return b;
}
__device__ __forceinline__ void xcd_barrier_complete(unsigned* bar, unsigned x, unsigned& nloc, unsigned& nx) {
    const unsigned G = gridDim.x * gridDim.y * gridDim.z;
    unsigned sum, cnt, mine, sp = 0u;
    for (;;) {
        sum = 0u; cnt = 0u; mine = 0u;
#pragma unroll
        for (unsigned j = 0; j < 16; ++j) { const unsigned c = xb_ld(&bar[XB_XCNT(j)]); sum += c; cnt += (c > 0u) ? 1u : 0u; mine = (j == x) ? c : mine; }
        if (sum == G) break;
        __builtin_amdgcn_s_sleep(1);
        if ((++sp & 255u) == 0u) { if (xb_ld(&bar[XB_TMO])) break; if (sp > XB_SPIN_CAP) { atomicAdd(&bar[XB_TMO], 1u); break; } }
    }
    nloc = mine > 0u ? mine : 1u; nx = cnt > 0u ? cnt : 1u;
}

__device__ __forceinline__ void xcd_barrier(const XcdBarrier& b) {
    asm volatile("s_waitcnt vmcnt(0)" ::: "memory");
    __syncthreads();
    if (threadIdx.x == 0) {
        unsigned* bar = b.bar;
        __builtin_amdgcn_s_waitcnt(0);
        unsigned nloc = b.st[0], nx = b.st[1];
        if (nloc == 0u) { xcd_barrier_complete(bar, b.x, nloc, nx); b.st[0] = nloc; b.st[1] = nx; }
        const unsigned old = xb_add(&bar[XB_XSUB(b.x)], 1u);
        const unsigned gen = old / nloc;
        if (old + 1u == (gen + 1u) * nloc) {
            __builtin_amdgcn_fence(__ATOMIC_RELEASE, "agent");
            asm volatile("s_waitcnt vmcnt(0)" ::: "memory");
            const unsigned og = xb_add(&bar[XB_TOP], 1u);
            const unsigned tg = og / nx;
            if (og + 1u == (tg + 1u) * nx) xb_add(&bar[XB_TOPGEN], 1u);
            else XB_SPIN(xb_ld(&bar[XB_TOPGEN]) == tg, bar);
            __builtin_amdgcn_fence(__ATOMIC_ACQUIRE, "agent");
            xb_add(&bar[XB_XGEN(b.x)], 1u);
            asm volatile("s_waitcnt vmcnt(0)" ::: "memory");
        } else {
            XB_SPIN(xb_ld(&bar[XB_XGEN(b.x)]) == gen, bar);
            __builtin_amdgcn_fence(__ATOMIC_ACQUIRE, "agent");
            asm volatile("s_waitcnt vmcnt(0)" ::: "memory");
        }
    }
    __syncthreads();
}

__global__ void __launch_bounds__(NWAVES * 64, 2) hybrid_fwd(Args args) {
    extern __shared__ __attribute__((aligned(16))) unsigned char lds_raw[];
    LAS unsigned char* lds = (LAS unsigned char*)lds_raw;
    const int G = gridDim.x, bid = blockIdx.x, NGW = G * NWAVES;
#define IDS int tid_ = threadIdx.x; asm volatile("" : "+v"(tid_)); const int lane = tid_ & 63, wave = __builtin_amdgcn_readfirstlane(tid_ >> 6), gw = bid * NWAVES + wave; (void)lane; (void)gw
    const int lo = args.ph_lo, hi = args.ph_hi;
    cg::grid_group grid = cg::this_grid();
    volatile LAS unsigned* bst = (volatile LAS unsigned*)(lds + LDS_BYTES - 16);
    if (threadIdx.x < 2) bst[threadIdx.x] = 0u;
    __syncthreads();
    XcdBarrier xbar = xcd_barrier_post((unsigned*)(args.ws + WS_CTL), bst);
#define IN(k) (lo <= (k) && (k) < hi)
#define KA KArgs ap = (KArgs)__builtin_amdgcn_kernarg_segment_ptr(); asm volatile("" : "+s"(ap)); unsigned char* ws = ap->ws; bf16* Pq = (bf16*)(ws + WS_PQ); bf16* Gt = (bf16*)(ws + WS_G); (void)Pq; (void)Gt
#define SEAM(k) do { if (IN(k) && IN((k) + 1)) xcd_barrier(xbar); } while (0)
    if (hi < 0) grid.sync();
    if (IN(0)) { IDS; KA; p0_prologue(ap, lds, gw, NGW, wave, lane); }
    SEAM(0);
    if (IN(1)) {
        KA;
        { pg8::Gemm g{(const bf16*)(ws + WS_H), (const bf16*)(ws + WS_WIN), MTOK, NPROJ, DM}; pg8::StaticOrder S; S.init(MTOK, NPROJ, G, bid);
          pg8::EpiProj E{Pq, Gt}; pg8::gemm_phase<pg8::EpiProj, pg8::StaticOrder, true, true>(lds, g, S, E); }
        __syncthreads();
        { pg8::Gemm g{(const bf16*)(ws + WS_HM), (const bf16*)(ws + WS_WMEM), MROWS, 512, DM}; pg8::StaticOrder S; S.init(MROWS, 512, G, bid);
          pg8::EpiBf16<0> E{(bf16*)(ws + WS_MKV), 512}; pg8::gemm_phase<pg8::EpiBf16<0>, pg8::StaticOrder, true, true>(lds, g, S, E); }
    }
    SEAM(1);
    if (IN(2)) { IDS; KA; p2_normrot(ap, gw, NGW, lane); }
    SEAM(2);
    if (IN(3)) {
        IDS; KA;
        for (int uid = gw; uid < 4096; uid += NGW) dilated_unit(lds + wave * 16384, Pq, (bf16*)(ws + WS_OA), uid >> 9, (uid >> 8) & 1, (uid >> 4) & 15, uid & 15, lane);
        for (int uid = gw; uid < 8192; uid += NGW) mem_unit(lds + wave * 16384, Pq, (const bf16*)(ws + WS_MKV), (bf16*)(ws + WS_OC), uid >> 10, (uid >> 8) & 3, uid & 255, lane);
        __syncthreads();
        dsa_select_phase(lds, Pq, (const bf16*)(ws + WS_KIF), (unsigned short*)(ws + WS_LISTS), (unsigned short*)(ws + WS_CNT), G, bid, wave, lane);
        xcd_barrier(xbar);
        dsa_attn_phase(lds, Pq, (const unsigned short*)(ws + WS_LISTS), (const unsigned short*)(ws + WS_CNT), (bf16*)(ws + WS_OB), bid, wave, lane);
    }
    SEAM(3);
    if (IN(4)) {
        KA; bf16* mrg = (bf16*)(ws + WS_MERGED);
        pg8::StaticOrder S; S.init(MTOK, DM, G, bid);
        { pg8::Gemm g{(const bf16*)(ws + WS_OA), (const bf16*)(ws + WS_WA), MTOK, DM, 128}; pg8::EpiGate<0> E{Gt, 0, mrg};
          pg8::gemm_phase<pg8::EpiGate<0>, pg8::StaticOrder, true, true>(lds, g, S, E); }
        __syncthreads();
        { pg8::Gemm g{(const bf16*)(ws + WS_OB), (const bf16*)(ws + WS_WB), MTOK, DM, 384}; pg8::EpiGate<1> E{Gt, 1024, mrg};
          pg8::gemm_phase<pg8::EpiGate<1>, pg8::StaticOrder, true, true>(lds, g, S, E); }
        __syncthreads();
        { pg8::Gemm g{(const bf16*)(ws + WS_OC), (const bf16*)(ws + WS_WC), MTOK, DM, 256}; pg8::EpiGate<1> E{Gt, 2048, mrg};
          pg8::gemm_phase<pg8::EpiGate<1>, pg8::StaticOrder, true, true>(lds, g, S, E); }
    }
    SEAM(4);
    if (IN(5)) {
        KA;
        pg8::Gemm g{(const bf16*)(ws + WS_MERGED), (const bf16*)(ws + WS_WO), MTOK, DM, DM}; pg8::StaticOrder S; S.init(MTOK, DM, G, bid);
        pg8::EpiRes E{ap->in[0], ap->out}; pg8::gemm_phase<pg8::EpiRes, pg8::StaticOrder, true, true>(lds, g, S, E);
    }
    SEAM(5);
    if (IN(6)) { IDS; KA; const float* xo_ = ap->out; const float* gm_ = ap->in[17]; for (int m = gw; m < MTOK; m += NGW) rms_row_to_bf16(xo_ + (size_t)m * DM, gm_, (bf16*)(ws + WS_H) + (size_t)m * DM, lane); }
    SEAM(6);
    if (IN(7)) {
        KA;
        pg8::Gemm g{(const bf16*)(ws + WS_H), (const bf16*)(ws + WS_W1), MTOK, FF, DM}; pg8::StaticOrder S; S.init(MTOK, FF, G, bid);
        pg8::EpiBf16<1> E{(bf16*)(ws + WS_HID), FF}; pg8::gemm_phase<pg8::EpiBf16<1>, pg8::StaticOrder, true, true>(lds, g, S, E);
    }
    SEAM(7);
    if (IN(8)) {
        KA; float* outp = ap->out;
        pg8::Gemm g{(const bf16*)(ws + WS_HID), (const bf16*)(ws + WS_W2), MTOK, DM, FF}; pg8::StaticOrder S; S.init(MTOK, DM, G, bid);
        pg8::EpiRes E{outp, outp}; pg8::gemm_phase<pg8::EpiRes, pg8::StaticOrder, true, true>(lds, g, S, E);
    }
#undef IN
#undef KA
#undef SEAM
}

#ifndef MK_ONE_LAUNCH
#define MK_ONE_LAUNCH 1
#endif
constexpr int N_PHASES = 9;
extern "C" void kernel_launch(void* const* d_in, const int* in_sizes, int n_in, void* d_out, int out_size, void* d_ws, size_t ws_size, hipStream_t stream) {
    static int grid = 0;
    if (grid == 0) {
        if (n_in != 20 || out_size != MTOK * DM || ws_size < WS_END) { fprintf(stderr, "kernel_launch: unexpected shapes: n_in %d out %d ws %zu (need %zu)\n", n_in, out_size, ws_size, (size_t)WS_END); grid = -1; return; }
        int dev = 0, cus = 0, per_cu = 0;
        hipGetDevice(&dev); hipDeviceGetAttribute(&cus, hipDeviceAttributeMultiprocessorCount, dev);
        if (hipFuncSetAttribute((const void*)hybrid_fwd, hipFuncAttributeMaxDynamicSharedMemorySize, LDS_BYTES) != hipSuccess) { fprintf(stderr, "kernel_launch: hipFuncSetAttribute failed\n"); grid = -1; return; }
        if (hipOccupancyMaxActiveBlocksPerMultiprocessor(&per_cu, (const void*)hybrid_fwd, NWAVES * 64, LDS_BYTES) != hipSuccess || per_cu < 1) { fprintf(stderr, "kernel_launch: occupancy query says %d\n", per_cu); per_cu = 1; }
        (void)hipGetLastError();
        grid = cus > 0 ? cus : 256;
    }
    if (grid < 0) return;
    if (hipMemsetAsync((char*)d_ws + WS_CTL, 0, CTL_BYTES, stream) != hipSuccess) { fprintf(stderr, "kernel_launch: hipMemsetAsync failed\n"); return; }
    Args a{};
    for (int i = 0; i < 20; ++i) a.in[i] = (const float*)d_in[i];
    a.out = (float*)d_out; a.ws = (unsigned char*)d_ws;
#if MK_ONE_LAUNCH
    a.ph_lo = 0; a.ph_hi = N_PHASES;
    void* kargs[] = {&a};
    hipError_t e = hipLaunchCooperativeKernel((const void*)hybrid_fwd, dim3(grid), dim3(NWAVES * 64), kargs, LDS_BYTES, stream);
    if (e != hipSuccess) fprintf(stderr, "kernel_launch: cooperative launch failed: %s (grid %d)\n", hipGetErrorString(e), grid);
#else
    for (int p = 0; p < N_PHASES; ++p) {
        a.ph_lo = p; a.ph_hi = p + 1;
        hipLaunchKernelGGL(hybrid_fwd, dim3(grid), dim3(NWAVES * 64), LDS_BYTES, stream, a);
    }
#endif
}
```
